# Optimizing an MI355X kernel written in HIP

```python
import math
import jax, jax.numpy as jnp
from jax import lax
import numpy as np

D_MODEL = 1024
BATCH = 32
SEQ = 2048
DEPTH = 2

N_MIXERS = 2
RMS_EPS = 1e-6

MLA_HEADS = 8
QK_NOPE_DIM = 128
QK_ROPE_DIM = 64
V_HEAD_DIM = 128
Q_LORA_RANK = 384
KV_LORA_RANK = 256
ROPE_THETA = 10000.0
Q_BLOCK = 128
MLA_WIDTH = MLA_HEADS * V_HEAD_DIM
MLA_QK_DIM = QK_NOPE_DIM + QK_ROPE_DIM
MLA_IN_WIDTH = Q_LORA_RANK + KV_LORA_RANK + QK_ROPE_DIM + MLA_WIDTH

HYENA_WIDTH = D_MODEL
HYENA_ORDER = 2
SHORT_CONV = 3
POS_EMB_DIM = 33
POS_BANDS = (POS_EMB_DIM - 1) // 2
FILTER_HIDDEN = 64
N_DIRS = 2
DECAY_TARGET = 1e-2
FAST_DECAY_PCT = 0.3
SLOW_DECAY_PCT = 1.5
MIN_DECAY = math.log(DECAY_TARGET) / SLOW_DECAY_PCT
MAX_DECAY = math.log(DECAY_TARGET) / FAST_DECAY_PCT
FILTER_OUT_GAIN = 0.05
HYENA_IN_WIDTH = (HYENA_ORDER + 1) * HYENA_WIDTH + HYENA_WIDTH

kernel_name = "mla_hyena_interleaved_encoder"


def rms_norm(x, g):
    xf = x.astype(jnp.float32)
    y = xf * lax.rsqrt(jnp.mean(xf * xf, axis=-1, keepdims=True) + RMS_EPS)
    return (y * g.astype(jnp.float32)).astype(x.dtype)


def rope_tables(L):
    inv = 1.0 / (ROPE_THETA ** (jnp.arange(0, QK_ROPE_DIM, 2, dtype=jnp.float32) / QK_ROPE_DIM))
    ang = jnp.arange(L, dtype=jnp.float32)[:, None] * inv[None, :]
    return jnp.cos(ang), jnp.sin(ang)


def apply_rope(x, cos, sin):
    xf = x.astype(jnp.float32)
    x1, x2 = xf[..., :QK_ROPE_DIM // 2], xf[..., QK_ROPE_DIM // 2:]
    out = jnp.concatenate([x1 * cos - x2 * sin, x1 * sin + x2 * cos], axis=-1)
    return out.astype(x.dtype)


def mla_mixer(h, w_in, q_norm, w_uq, kv_norm, w_ukv, w_out):
    B, L, _ = h.shape
    proj = h @ w_in
    s1 = Q_LORA_RANK
    s2 = s1 + KV_LORA_RANK
    s3 = s2 + QK_ROPE_DIM
    c_q, c_kv, k_pe, gate = proj[..., :s1], proj[..., s1:s2], proj[..., s2:s3], proj[..., s3:]
    q = (rms_norm(c_q, q_norm) @ w_uq).reshape(B, L, MLA_HEADS, MLA_QK_DIM)
    q_nope, q_pe = q[..., :QK_NOPE_DIM], q[..., QK_NOPE_DIM:]
    kv = (rms_norm(c_kv, kv_norm) @ w_ukv).reshape(B, L, MLA_HEADS, QK_NOPE_DIM + V_HEAD_DIM)
    k_nope, v = kv[..., :QK_NOPE_DIM], kv[..., QK_NOPE_DIM:]
    cos, sin = rope_tables(L)
    q_pe = apply_rope(q_pe, cos[:, None, :], sin[:, None, :])
    k_pe = apply_rope(k_pe, cos, sin)
    scale = MLA_QK_DIM ** -0.5
    n_blk = L // Q_BLOCK

    def to_blocks(t):
        return jnp.moveaxis(t.reshape(B, n_blk, Q_BLOCK, *t.shape[2:]), 1, 0)

    def attend(blk):
        qn, qp = blk
        s = (jnp.einsum('bqhd,bkhd->bhqk', qn, k_nope)
             + jnp.einsum('bqhr,bkr->bhqk', qp, k_pe))
        p = jax.nn.softmax(s.astype(jnp.float32) * scale, axis=-1).astype(v.dtype)
        return jnp.einsum('bhqk,bkhd->bqhd', p, v)

    o = lax.map(attend, (to_blocks(q_nope), to_blocks(q_pe)))
    o = jnp.moveaxis(o, 0, 1).reshape(B, L, MLA_WIDTH)
    return (o * jax.nn.silu(gate)) @ w_out


def hyena_filters(L, w1, b1, w2, b2, w3, b3, w4, freq):
    f32 = jnp.float32
    t = jnp.linspace(0.0, 1.0, L, dtype=f32)[:, None]
    w = 2.0 * math.pi * jnp.arange(L, dtype=f32) / L
    bands = jnp.linspace(1e-4, POS_BANDS - 1, POS_BANDS, dtype=f32)
    fw = w[:, None] * bands[None, :]
    z = jnp.concatenate([t, jnp.cos(fw), -jnp.sin(fw)], axis=-1)
    fr = freq.astype(f32)
    a = jnp.sin(fr * (z @ w1.astype(f32) + b1.astype(f32)))
    a = jnp.sin(fr * (a @ w2.astype(f32) + b2.astype(f32)))
    a = jnp.sin(fr * (a @ w3.astype(f32) + b3.astype(f32)))
    hf = (a @ w4.astype(f32)).reshape(L, HYENA_ORDER, N_DIRS, HYENA_WIDTH)
    deltas = jnp.abs(jnp.linspace(MIN_DECAY, MAX_DECAY, HYENA_WIDTH, dtype=f32))
    decay = jnp.exp(-t * deltas[None, :])
    return hf * decay[:, None, None, :]


def two_sided_kernel(h_fwd, h_bwd):
    return jnp.concatenate([h_fwd, jnp.zeros_like(h_fwd[:1]), h_bwd[:0:-1]], axis=0)


def bidir_long_conv(u, k, bias):
    L = u.shape[1]
    uf = u.astype(jnp.float32)
    spec = jnp.fft.rfft(uf, n=2 * L, axis=1) * jnp.fft.rfft(k, n=2 * L, axis=0)[None]
    y = jnp.fft.irfft(spec, n=2 * L, axis=1)[:, :L]
    return (y + uf * bias.astype(jnp.float32)).astype(u.dtype)


def hyena_mixer(h, w_in, conv_w, conv_b, filt_w1, filt_b1, filt_w2, filt_b2,
                filt_w3, filt_b3, filt_w4, filt_freq, filt_bias, w_out):
    B, L, _ = h.shape
    proj = h @ w_in
    u, gate = proj[..., :(HYENA_ORDER + 1) * HYENA_WIDTH], proj[..., (HYENA_ORDER + 1) * HYENA_WIDTH:]
    pad = SHORT_CONV // 2
    up = jnp.pad(u, ((0, 0), (pad, pad), (0, 0)))
    u = conv_b + sum(up[:, j:j + L] * conv_w[j] for j in range(SHORT_CONV))
    x1 = u[..., :HYENA_WIDTH]
    x2 = u[..., HYENA_WIDTH:2 * HYENA_WIDTH]
    v = u[..., 2 * HYENA_WIDTH:]
    filt = hyena_filters(L, filt_w1, filt_b1, filt_w2, filt_b2, filt_w3, filt_b3, filt_w4, filt_freq)
    z = v
    for n, g_n in enumerate((x1, x2)):
        k = two_sided_kernel(filt[:, n, 0], filt[:, n, 1])
        z = g_n * bidir_long_conv(z, k, filt_bias[n])
    return (z * jax.nn.silu(gate)) @ w_out


def setup_inputs(seed: int = 0) -> dict:
    key = jax.random.key(seed)
    ks = iter(jax.random.split(key, 32))
    f32 = jnp.float32

    def nrm(shape, scale):
        return jax.random.normal(next(ks), shape, f32) * scale

    def gain(n):
        return jnp.ones((n,), f32) + nrm((n,), 0.01)

    d = D_MODEL
    return {
        "x": nrm((BATCH, SEQ, d), 1.0),
        "l0_norm": gain(d),
        "l0_w_in": nrm((d, MLA_IN_WIDTH), d ** -0.5),
        "l0_q_norm": gain(Q_LORA_RANK),
        "l0_w_uq": nrm((Q_LORA_RANK, MLA_HEADS * MLA_QK_DIM), Q_LORA_RANK ** -0.5),
        "l0_kv_norm": gain(KV_LORA_RANK),
        "l0_w_ukv": nrm((KV_LORA_RANK, MLA_HEADS * (QK_NOPE_DIM + V_HEAD_DIM)), KV_LORA_RANK ** -0.5),
        "l0_w_out": nrm((MLA_WIDTH, d), MLA_WIDTH ** -0.5),
        "l1_norm": gain(d),
        "l1_w_in": nrm((d, HYENA_IN_WIDTH), d ** -0.5),
        "l1_conv_w": nrm((SHORT_CONV, (HYENA_ORDER + 1) * HYENA_WIDTH), SHORT_CONV ** -0.5),
        "l1_conv_b": nrm(((HYENA_ORDER + 1) * HYENA_WIDTH,), 0.02),
        "l1_filt_w1": nrm((POS_EMB_DIM, FILTER_HIDDEN), POS_EMB_DIM ** -0.5),
        "l1_filt_b1": nrm((FILTER_HIDDEN,), 0.1),
        "l1_filt_w2": nrm((FILTER_HIDDEN, FILTER_HIDDEN), FILTER_HIDDEN ** -0.5),
        "l1_filt_b2": nrm((FILTER_HIDDEN,), 0.1),
        "l1_filt_w3": nrm((FILTER_HIDDEN, FILTER_HIDDEN), FILTER_HIDDEN ** -0.5),
        "l1_filt_b3": nrm((FILTER_HIDDEN,), 0.1),
        "l1_filt_w4": nrm((FILTER_HIDDEN, HYENA_ORDER * N_DIRS * HYENA_WIDTH), FILTER_OUT_GAIN * FILTER_HIDDEN ** -0.5),
        "l1_filt_freq": jnp.ones((FILTER_HIDDEN,), f32) + nrm((FILTER_HIDDEN,), 0.1),
        "l1_filt_bias": nrm((HYENA_ORDER, HYENA_WIDTH), 0.2),
        "l1_w_out": nrm((HYENA_WIDTH, d), HYENA_WIDTH ** -0.5),
        "final_norm": gain(d),
    }


def reference(x, l0_norm, l0_w_in, l0_q_norm, l0_w_uq, l0_kv_norm, l0_w_ukv, l0_w_out,
              l1_norm, l1_w_in, l1_conv_w, l1_conv_b, l1_filt_w1, l1_filt_b1, l1_filt_w2,
              l1_filt_b2, l1_filt_w3, l1_filt_b3, l1_filt_w4, l1_filt_freq, l1_filt_bias,
              l1_w_out, final_norm):
    mixers = (mla_mixer, hyena_mixer)
    layers = (
        (l0_norm, (l0_w_in, l0_q_norm, l0_w_uq, l0_kv_norm, l0_w_ukv, l0_w_out)),
        (l1_norm, (l1_w_in, l1_conv_w, l1_conv_b, l1_filt_w1, l1_filt_b1, l1_filt_w2, l1_filt_b2,
                   l1_filt_w3, l1_filt_b3, l1_filt_w4, l1_filt_freq, l1_filt_bias, l1_w_out)),
    )
    h = x
    for i in range(DEPTH):
        g, params = layers[i]
        h = h + mixers[i % N_MIXERS](rms_norm(h, g), *params)
    return rms_norm(h, final_norm)
```

```cpp
#include <hip/hip_runtime.h>
#include <hip/hip_cooperative_groups.h>
#include <cstdio>
#include <cstdint>
namespace cg = cooperative_groups;

#define LAS __attribute__((address_space(3)))
typedef unsigned short bf16_t;
typedef short bf16x8 __attribute__((ext_vector_type(8)));
typedef short s16x4 __attribute__((ext_vector_type(4)));
typedef float f32x4 __attribute__((ext_vector_type(4)));
typedef float f32x16 __attribute__((ext_vector_type(16)));
typedef unsigned u32x4 __attribute__((ext_vector_type(4)));
typedef unsigned u32x2 __attribute__((ext_vector_type(2)));

constexpr int DM = 1024, NB = 32, SEQ = 2048, NTOK = NB * SEQ;
constexpr int NHEAD = 8, QKD = 192, NOPE = 128, ROPE = 64, VD = 128, QR = 384, KVR = 256;
constexpr int N0P = 1792;
constexpr float RMS_EPS = 1e-6f;

constexpr size_t MiB = 1u << 20;
constexpr size_t WS_W0   = 0;
constexpr size_t WS_WUQ  = 4 * MiB;
constexpr size_t WS_WUKV = 6 * MiB;
constexpr size_t WS_WO0  = 7 * MiB;
constexpr size_t WS_W1   = 9 * MiB;
constexpr size_t WS_WO1  = 17 * MiB;
constexpr size_t WS_ROPE = 19 * MiB;
constexpr size_t WS_GEN  = 20 * MiB;
constexpr size_t WS_BAR  = 38 * MiB;
constexpr size_t WS_R1   = 40 * MiB;
constexpr size_t WS_R2   = 168 * MiB;
constexpr size_t WS_SSQ  = 36 * MiB;
constexpr size_t WS_CQN  = 456 * MiB;
constexpr size_t WS_CKVN = 504 * MiB;
constexpr size_t WS_KPE  = 536 * MiB;
constexpr size_t WS_Q    = 544 * MiB;
constexpr size_t WS_KV   = 736 * MiB;
constexpr size_t WS_HB   = 864 * MiB;
constexpr size_t WS_UT   = 296 * MiB;
constexpr size_t WS_ZG   = 736 * MiB;
constexpr size_t WS_END  = 992 * MiB;

constexpr int LDS_BYTES = 147456;

__device__ __forceinline__ unsigned cvtpk(float lo, float hi) { unsigned r; asm volatile("v_cvt_pk_bf16_f32 %0, %1, %2" : "=v"(r) : "v"(lo), "v"(hi)); return r; }
__device__ __forceinline__ float bf2f(unsigned short h) { return __uint_as_float(((unsigned)h) << 16); }
__device__ __forceinline__ float bflo(unsigned w) { return __uint_as_float(w << 16); }
__device__ __forceinline__ float bfhi(unsigned w) { return __uint_as_float(w & 0xffff0000u); }
__device__ __forceinline__ unsigned short f2bf(float f) { return (unsigned short)(cvtpk(f, 0.f) & 0xffffu); }
__device__ __forceinline__ float wave_sum(float v) {
#pragma unroll
    for (int o = 1; o < 64; o <<= 1) v += __shfl_xor(v, o);
    return v;
}
__device__ __forceinline__ float silu_f(float x) { return x * __builtin_amdgcn_rcpf(1.f + __builtin_amdgcn_exp2f(-1.4426950408889634f * x)); }
__device__ __forceinline__ void sincos_cw(float x, float& s, float& c) {
    const float k = rintf(x * 0.63661977236758134f);
    float r = fmaf(-k, 1.5703125f, x); r = fmaf(-k, 4.837512969970703125e-4f, r); r = fmaf(-k, 7.54978995489188216e-8f, r);
    const float z = r * r;
    const float sp = fmaf(fmaf(fmaf(-1.9515295891e-4f, z, 8.3321608736e-3f), z, -1.6666654611e-1f) * z, r, r);
    const float cp = fmaf(fmaf(fmaf(2.443315711809948e-5f, z, -1.388731625493765e-3f), z, 4.166664568298827e-2f), z * z, fmaf(-0.5f, z, 1.f));
    const int q = ((int)k) & 3;
    const float ss = (q & 1) ? cp : sp, cc = (q & 1) ? sp : cp;
    s = (q & 2) ? -ss : ss; c = ((q + 1) & 2) ? -cc : cc;
}
__device__ __forceinline__ float sin_cw(float x) { float s, c; sincos_cw(x, s, c); return s; }
namespace pg8 {
#define PG8_LAS __attribute__((address_space(3)))
typedef unsigned short bf16_t;
typedef short bf16x8 __attribute__((ext_vector_type(8)));
typedef float f32x4 __attribute__((ext_vector_type(4)));
typedef unsigned u32x4 __attribute__((ext_vector_type(4)));
constexpr int BM = 256, BK = 64, HALF = 128, HTB = HALF * BK * 2  , STAGE_BYTES = 8 * HTB, NXCD = 8, WGM = 8;

__host__ __device__ __forceinline__ int lds_byte(int r, int c) { const int st = (r >> 4) * 2 + (c >> 5), rr = r & 15, cc = c & 31, ob = rr * 64 + cc * 2; return st * 1024 + (ob ^ (((ob >> 9) & 1) << 5)); }
__host__ __device__ __forceinline__ void stage_rc(int b, int& R, int& C) { const int st = b / 1024, sb = b % 1024, swz = sb ^ (((sb >> 9) & 1) << 5); R = (st >> 1) * 16 + swz / 64; C = (st & 1) * 32 + (swz % 64) / 2; }
__host__ __device__ __forceinline__ int perm32(int rho) { const int n = rho >> 4, i = rho & 15; return 8 * (i >> 2) + 4 * n + (i & 3); }

struct Unit { int pm, pn; };
struct Gemm { const bf16_t* A; const bf16_t* Bt; int M, N, K; };

struct StaticOrder {
    int nM, nN, nwg, G, c;
    __host__ __device__ void init(int M, int N, int G_, int c_) { nM = M / BM; nN = N / BM; nwg = nM * nN; G = G_; c = c_; }
    __host__ __device__ bool next(int i, Unit& u) const {
        const long L = (long)i * G + c; if (L >= nwg) return false;
        int wgid = (int)L; { const int q = nwg / NXCD, r = nwg % NXCD, xcd = wgid % NXCD, off = wgid / NXCD; wgid = (xcd < r ? xcd * (q + 1) : r * (q + 1) + (xcd - r) * q) + off; }
        const int nig = WGM * nN, gid = wgid / nig, fm = gid * WGM, gsz = (nM - fm) < WGM ? (nM - fm) : WGM;
        u.pm = fm + ((wgid % nig) % gsz); u.pn = (wgid % nig) / gsz; return true;
    }
    __device__ __forceinline__ void a_ready(const Unit&) const {}
    __device__ __forceinline__ void done(const Unit&) const {}
};

template <class Epi, class Sched, bool ALIGN_EPI = false, bool SP2 = false>
__device__ __forceinline__ void gemm_phase(PG8_LAS unsigned char* lds, const Gemm g, const Sched& S, const Epi& E) {
    int tid_o = threadIdx.x; asm volatile("" : "+v"(tid_o));
    const int tid = tid_o, wid = __builtin_amdgcn_readfirstlane(tid >> 6), lane = tid & 63, wr = wid >> 2, wc = wid & 3, fr = lane & 15, fq = lane >> 4;
    const int K = g.K, nt = K / BK;
    unsigned voffA[2], voffB[2];
#pragma unroll
    for (int i = 0; i < 2; ++i) { int R, C; stage_rc(tid * 16 + i * 8192, R, C); const int Rb = Epi::PERM ? ((R & ~31) + perm32(R & 31)) : R;
        voffA[i] = (unsigned)(R * K + C) * 2u; voffB[i] = (unsigned)(Rb * K + C) * 2u; }
    const size_t kstep = (size_t)(BK * 2);
    const size_t hstep = (size_t)HALF * K * 2;
    const size_t tstep = 2 * hstep;
    const unsigned ldsw = (unsigned)wid * 1024u;
    const int aoff = lds_byte(wr * 64 + fr, fq * 8), boff = lds_byte(wc * 32 + fr, fq * 8);
#define PG8_SA(b, h) (((b) * 2 + (h)) * HTB)
#define PG8_SB(b, h) ((4 + (b) * 2 + (h)) * HTB)
#define PG8_STAGE(bufoff, gbase, voff) do { _Pragma("unroll") for (int _i = 0; _i < 2; ++_i) \
        __builtin_amdgcn_global_load_lds((const unsigned*)((const char*)(gbase) + (voff)[_i]), (PG8_LAS unsigned*)(lds + (bufoff) + ldsw + _i * 8192), 16, 0, 0); } while (0)
#define PG8_LDA(dst, b, h) do { _Pragma("unroll") for (int m = 0; m < 4; ++m) _Pragma("unroll") for (int k = 0; k < 2; ++k) dst[m][k] = *(const PG8_LAS bf16x8*)(lds + PG8_SA(b, h) + aoff + m * 2048 + k * 1024); } while (0)
#define PG8_LDB(dst, b, h) do { _Pragma("unroll") for (int n = 0; n < 2; ++n) _Pragma("unroll") for (int k = 0; k < 2; ++k) dst[n][k] = *(const PG8_LAS bf16x8*)(lds + PG8_SB(b, h) + boff + n * 2048 + k * 1024); } while (0)
#define PG8_MMA(ai, bj, At, Bt) do { __builtin_amdgcn_s_setprio(1); _Pragma("unroll") for (int m = 0; m < 4; ++m) _Pragma("unroll") for (int n = 0; n < 2; ++n) _Pragma("unroll") for (int k = 0; k < 2; ++k) \
        acc[ai][bj][m][n] = __builtin_amdgcn_mfma_f32_16x16x32_bf16(Bt[n][k], At[m][k], acc[ai][bj][m][n], 0, 0, 0); __builtin_amdgcn_s_setprio(0); } while (0)
#define PG8_WAIT_V(n) asm volatile("s_waitcnt vmcnt(" #n ")" ::: "memory")
#define PG8_WAIT_L(n) asm volatile("s_waitcnt lgkmcnt(" #n ")" ::: "memory")
#define PG8_BAR __builtin_amdgcn_s_barrier()
#define PG8_SCHED __builtin_amdgcn_sched_barrier(0)
    Unit cur, nxt; int ui = 0;
    if (!S.next(0, cur)) return;
    f32x4 acc[2][2][4][2];
#pragma unroll
    for (int a = 0; a < 2; ++a)
#pragma unroll
        for (int b = 0; b < 2; ++b)
#pragma unroll
            for (int m = 0; m < 4; ++m)
#pragma unroll
                for (int n = 0; n < 2; ++n) acc[a][b][m][n] = (f32x4){0.f, 0.f, 0.f, 0.f};
    bf16x8 At[4][2], B0[2][2], B1[2][2];
    const char* cA = (const char*)g.A + (size_t)cur.pm * tstep; const char* cB = (const char*)g.Bt + (size_t)cur.pn * tstep;
    S.a_ready(cur);
    if constexpr (SP2) {
        PG8_STAGE(PG8_SB(0, 0), cB, voffB); PG8_STAGE(PG8_SB(0, 1), cB + hstep, voffB); PG8_STAGE(PG8_SA(0, 0), cA, voffA); PG8_STAGE(PG8_SA(0, 1), cA + hstep, voffA);
        if (wr == 1) PG8_BAR;
        PG8_WAIT_V(2); PG8_BAR;
        PG8_STAGE(PG8_SB(1, 0), cB + kstep, voffB); PG8_STAGE(PG8_SA(1, 0), cA + kstep, voffA); PG8_STAGE(PG8_SB(1, 1), cB + hstep + kstep, voffB);
        PG8_WAIT_V(6); PG8_BAR;
    } else {
        PG8_STAGE(PG8_SB(0, 0), cB, voffB); PG8_STAGE(PG8_SA(0, 0), cA, voffA); PG8_STAGE(PG8_SB(0, 1), cB + hstep, voffB); PG8_STAGE(PG8_SA(0, 1), cA + hstep, voffA);
        if (wr == 1) PG8_BAR;
        PG8_WAIT_V(4); PG8_BAR;
        PG8_STAGE(PG8_SB(1, 0), cB + kstep, voffB); PG8_STAGE(PG8_SA(1, 0), cA + kstep, voffA); PG8_STAGE(PG8_SB(1, 1), cB + hstep + kstep, voffB);
        PG8_WAIT_V(6); PG8_BAR;
    }
    for (;;) {
        const bool has_next = S.next(ui + 1, nxt);
        const char* nA = has_next ? (const char*)g.A + (size_t)nxt.pm * tstep : cA; const char* nB = has_next ? (const char*)g.Bt + (size_t)nxt.pn * tstep : cB;
        for (int t = 0; t < nt; t += 2) {
            const bool last = (t == nt - 2);
            const char* a1 = cA + (size_t)(t + 1) * kstep;
            const char* a2 = last ? nA : cA + (size_t)(t + 2) * kstep; const char* b2 = last ? nB : cB + (size_t)(t + 2) * kstep;
            const char* a3 = a2 + kstep; const char* b3 = b2 + kstep;
            if (last && has_next) S.a_ready(nxt);
            if constexpr (SP2) {
            PG8_LDB(B0, 0, 0); PG8_LDB(B1, 0, 1); PG8_SCHED; PG8_LDA(At, 0, 0); PG8_STAGE(PG8_SA(1, 1), a1 + hstep, voffA);
            PG8_WAIT_V(8); PG8_WAIT_L(0); PG8_BAR; PG8_MMA(0, 0, At, B0); PG8_MMA(0, 1, At, B1); PG8_BAR; PG8_SCHED;
            PG8_LDA(At, 0, 1); PG8_STAGE(PG8_SB(0, 0), b2, voffB); PG8_STAGE(PG8_SB(0, 1), b2 + hstep, voffB); PG8_STAGE(PG8_SA(0, 0), a2, voffA);
            PG8_WAIT_V(8); PG8_WAIT_L(0); PG8_BAR; PG8_MMA(1, 0, At, B0); PG8_MMA(1, 1, At, B1); PG8_BAR; PG8_SCHED;
            PG8_LDB(B0, 1, 0); PG8_LDB(B1, 1, 1); PG8_SCHED; PG8_LDA(At, 1, 0); PG8_STAGE(PG8_SA(0, 1), a2 + hstep, voffA);
            PG8_WAIT_V(8); PG8_WAIT_L(0); PG8_BAR; PG8_MMA(0, 0, At, B0); PG8_MMA(0, 1, At, B1); PG8_BAR; PG8_SCHED;
            PG8_LDA(At, 1, 1); PG8_STAGE(PG8_SB(1, 0), b3, voffB); PG8_STAGE(PG8_SB(1, 1), b3 + hstep, voffB); PG8_STAGE(PG8_SA(1, 0), a3, voffA);
            PG8_WAIT_V(8); PG8_WAIT_L(0); PG8_BAR; PG8_MMA(1, 0, At, B0); PG8_MMA(1, 1, At, B1); PG8_BAR; PG8_SCHED;
            } else {
            PG8_LDB(B0, 0, 0); PG8_SCHED; PG8_LDA(At, 0, 0); PG8_STAGE(PG8_SA(1, 1), a1 + hstep, voffA);
            PG8_WAIT_L(8); PG8_BAR; PG8_WAIT_L(0); PG8_MMA(0, 0, At, B0); PG8_BAR; PG8_SCHED;
            PG8_LDB(B1, 0, 1); PG8_STAGE(PG8_SB(0, 0), b2, voffB);
            PG8_BAR; PG8_WAIT_L(0); PG8_MMA(0, 1, At, B1); PG8_BAR;
            PG8_LDA(At, 0, 1); PG8_STAGE(PG8_SA(0, 0), a2, voffA);
            PG8_BAR; PG8_WAIT_L(0); PG8_MMA(1, 0, At, B0); PG8_BAR; PG8_SCHED;
            PG8_STAGE(PG8_SB(0, 1), b2 + hstep, voffB);
            PG8_WAIT_V(6); PG8_BAR; PG8_MMA(1, 1, At, B1); PG8_BAR;
            PG8_LDB(B0, 1, 0); PG8_SCHED; PG8_LDA(At, 1, 0); PG8_STAGE(PG8_SA(0, 1), a2 + hstep, voffA);
            PG8_WAIT_L(8); PG8_BAR; PG8_WAIT_L(0); PG8_MMA(0, 0, At, B0); PG8_BAR; PG8_SCHED;
            PG8_LDB(B1, 1, 1); PG8_STAGE(PG8_SB(1, 0), b3, voffB);
            PG8_BAR; PG8_WAIT_L(0); PG8_MMA(0, 1, At, B1); PG8_BAR;
            PG8_LDA(At, 1, 1); PG8_STAGE(PG8_SA(1, 0), a3, voffA);
            PG8_BAR; PG8_WAIT_L(0); PG8_MMA(1, 0, At, B0); PG8_BAR; PG8_SCHED;
            PG8_STAGE(PG8_SB(1, 1), b3 + hstep, voffB);
            PG8_WAIT_V(6); PG8_BAR; PG8_MMA(1, 1, At, B1); PG8_BAR;
            }
        }
        if constexpr (ALIGN_EPI) { if (wr == 0) PG8_BAR; }
        if constexpr (!Epi::AFTER_DRAIN) { E(acc, cur, wr, wc, fr, fq); S.done(cur); }
        if (!has_next) break;
#pragma unroll
        for (int a = 0; a < 2; ++a)
#pragma unroll
            for (int b = 0; b < 2; ++b)
#pragma unroll
                for (int m = 0; m < 4; ++m)
#pragma unroll
                    for (int n = 0; n < 2; ++n) acc[a][b][m][n] = (f32x4){0.f, 0.f, 0.f, 0.f};
        cur = nxt; cA = nA; cB = nB; ++ui;
        if constexpr (ALIGN_EPI) { if (wr == 1) PG8_BAR; }
    }
    PG8_WAIT_V(0);
    if constexpr (!ALIGN_EPI) { if (wr == 0) PG8_BAR; }
    PG8_BAR;
    if constexpr (Epi::AFTER_DRAIN) { E.fused(acc, cur, wr, wc, fr, fq, lds, wid, lane); S.done(cur); }
#undef PG8_SA
#undef PG8_SB
#undef PG8_STAGE
#undef PG8_LDA
#undef PG8_LDB
#undef PG8_MMA
#undef PG8_WAIT_V
#undef PG8_WAIT_L
#undef PG8_BAR
#undef PG8_SCHED
}
}

template <class F> struct EpiRows {
    static constexpr bool PERM = true, AFTER_DRAIN = false;
    F f;
    __device__ __forceinline__ void operator()(const pg8::f32x4 (&acc)[2][2][4][2], const pg8::Unit& u, int, int, int, int) const {
        int t_ = threadIdx.x; asm volatile("" : "+v"(t_));
        const int ln_ = t_ & 63, wd_ = t_ >> 6, wr = wd_ >> 2, wc = wd_ & 3, fr = ln_ & 15, fq = ln_ >> 4;
        const int row0 = u.pm * 256 + wr * 64 + fr, col0 = u.pn * 256 + wc * 32 + 8 * fq;
#pragma unroll
        for (int ai = 0; ai < 2; ++ai)
#pragma unroll
            for (int m = 0; m < 4; ++m)
#pragma unroll
                for (int bj = 0; bj < 2; ++bj) f(row0 + ai * 128 + m * 16, col0 + bj * 128, acc[ai][bj][m][0], acc[ai][bj][m][1]);
    }
};
__device__ __forceinline__ u32x4 pack8(f32x4 a, f32x4 b) { u32x4 w; w.x = cvtpk(a[0], a[1]); w.y = cvtpk(a[2], a[3]); w.z = cvtpk(b[0], b[1]); w.w = cvtpk(b[2], b[3]); return w; }
__device__ __forceinline__ f32x4 silu4(f32x4 v) { return (f32x4){silu_f(v[0]), silu_f(v[1]), silu_f(v[2]), silu_f(v[3])}; }
__device__ __forceinline__ void rope8(const float* rope, int pos, int q, f32x4& v0, f32x4& v1) {
    const f32x4 c = *(const f32x4*)(rope + pos * 32 + 4 * q), s = *(const f32x4*)(rope + SEQ * 32 + pos * 32 + 4 * q);
    const f32x4 a = v0 * c - v1 * s, b = v0 * s + v1 * c; v0 = a; v1 = b;
}
__device__ __forceinline__ float sq8(f32x4 a, f32x4 b) { return (a[0] * a[0] + a[1] * a[1]) + (a[2] * a[2] + a[3] * a[3]) + (b[0] * b[0] + b[1] * b[1]) + (b[2] * b[2] + b[3] * b[3]); }
__device__ __forceinline__ float row_sum4(float p) { p += __shfl_xor(p, 16); p += __shfl_xor(p, 32); return p; }
__device__ __forceinline__ bool fq_is0() { return (threadIdx.x & 48) == 0; }
struct F_G1 { bf16_t* cq; bf16_t* ckv; float* ssq_q; float* ssq_kv; bf16_t* kpe; bf16_t* sg; const float* rope;
    __device__ __forceinline__ void operator()(int row, int col, f32x4 v0, f32x4 v1) const {
        if (col < 640) { const float p = row_sum4(sq8(v0, v1));
            if (col < 384) { *(u32x4*)(cq + (size_t)row * 384 + col) = pack8(v0, v1); if (fq_is0()) unsafeAtomicAdd(ssq_q + row, p); }
            else { *(u32x4*)(ckv + (size_t)row * 256 + (col - 384)) = pack8(v0, v1); if (fq_is0()) unsafeAtomicAdd(ssq_kv + row, p); } }
        else if (col < 704) { rope8(rope, row & (SEQ - 1), (col - 640) >> 3, v0, v1); *(u32x4*)(kpe + (size_t)row * 64 + (col - 640)) = pack8(v0, v1); }
        else if (col >= 768) { *(u32x4*)(sg + (size_t)row * 1024 + (col - 768)) = pack8(silu4(v0), silu4(v1)); }
    } };
struct F_G2Q { bf16_t* q; const float* rope;
    __device__ __forceinline__ void operator()(int row, int col, f32x4 v0, f32x4 v1) const {
        const int j = col % 192;
        if (j >= 128) rope8(rope, row & (SEQ - 1), (j - 128) >> 3, v0, v1);
        *(u32x4*)(q + (size_t)row * 1536 + col) = pack8(v0, v1);
    } };
struct F_G2KV { bf16_t* o; const float* ssq;
    __device__ __forceinline__ void operator()(int row, int col, f32x4 v0, f32x4 v1) const {
        const float r = __builtin_amdgcn_rsqf(ssq[row] * (1.f / 256.f) + RMS_EPS); *(u32x4*)(o + (size_t)row * 2048 + col) = pack8(v0 * r, v1 * r); } };
struct F_BF16 { bf16_t* o; size_t ld;
    __device__ __forceinline__ void operator()(int row, int col, f32x4 v0, f32x4 v1) const { *(u32x4*)(o + (size_t)row * ld + col) = pack8(v0, v1); } };
struct F_SILU { bf16_t* o;
    __device__ __forceinline__ void operator()(int row, int col, f32x4 v0, f32x4 v1) const { *(u32x4*)(o + (size_t)row * 1024 + col) = pack8(silu4(v0), silu4(v1)); } };
struct F_RES { const float* base; float* out;
    __device__ __forceinline__ void operator()(int row, int col, f32x4 v0, f32x4 v1) const {
        const size_t i = (size_t)row * 1024 + col; const f32x4 b0 = *(const f32x4*)(base + i), b1 = *(const f32x4*)(base + i + 4);
        *(f32x4*)(out + i) = b0 + v0; *(f32x4*)(out + i + 4) = b1 + v1; } };
struct F_RES1 { const float* base; float* out; bf16_t* hb; float* ssq;
    __device__ __forceinline__ void operator()(int row, int col, f32x4 v0, f32x4 v1) const {
        const size_t i = (size_t)row * 1024 + col; const f32x4 h0 = *(const f32x4*)(base + i) + v0, h1 = *(const f32x4*)(base + i + 4) + v1;
        *(f32x4*)(out + i) = h0; *(f32x4*)(out + i + 4) = h1; *(u32x4*)(hb + i) = pack8(h0, h1);
        const float p = row_sum4(sq8(h0, h1)); if (fq_is0()) unsafeAtomicAdd(ssq + row, p); } };
struct F_UT { bf16_t* o; const float* ssq;
    __device__ __forceinline__ void operator()(int row, int col, f32x4 v0, f32x4 v1) const {
        const f32x4 s0 = *(const f32x4*)(ssq + col), s1 = *(const f32x4*)(ssq + col + 4); f32x4 r0, r1;
#pragma unroll
        for (int e = 0; e < 4; ++e) { r0[e] = __builtin_amdgcn_rsqf(s0[e] * (1.f / 1024.f) + RMS_EPS); r1[e] = __builtin_amdgcn_rsqf(s1[e] * (1.f / 1024.f) + RMS_EPS); }
        *(u32x4*)(o + (size_t)row * NTOK + col) = pack8(v0 * r0, v1 * r1); } };
struct F_SILU1 { bf16_t* o; const float* ssq;
    __device__ __forceinline__ void operator()(int row, int col, f32x4 v0, f32x4 v1) const {
        const float r = __builtin_amdgcn_rsqf(ssq[row] * (1.f / 1024.f) + RMS_EPS); *(u32x4*)(o + (size_t)row * 1024 + col) = pack8(silu4(v0 * r), silu4(v1 * r)); } };

namespace att {
constexpr int NW = 8, QBLK = 32, KVBLK = 64;
constexpr float SCALE = 0.07216878364870322f;
constexpr float THR = 8.f;
constexpr int BUF_KN = 0, BUF_KP = 16384, BUF_V = 24576, BUF_BYTES = 40960, LDS_WS = 3 * BUF_BYTES;
constexpr int SHM_ATTN = LDS_WS + NW * 64 * 4;
#define SBAR() __builtin_amdgcn_sched_barrier(0)
__device__ __forceinline__ int crow(int r, int hi) { return (r & 3) + 8 * (r >> 2) + 4 * hi; }

__device__ __forceinline__ void partialSM(f32x16& p0, f32x16& p1, float& m_reg, float& mn, float& alpha, float rq) {
  constexpr float C = SCALE * 1.4426950408889634f;
  float pmax = p0[0];
#pragma unroll
  for (int r = 1; r < 16; ++r) pmax = fmaxf(pmax, p0[r]);
#pragma unroll
  for (int r = 0; r < 16; ++r) pmax = fmaxf(pmax, p1[r]);
  { auto rr = __builtin_amdgcn_permlane32_swap(__float_as_uint(pmax), __float_as_uint(pmax), false, false);
    pmax = fmaxf(__uint_as_float(rr[0]), __uint_as_float(rr[1])) * rq; }
  if (__builtin_expect(__all(pmax - m_reg <= THR / SCALE), 1)) { mn = m_reg; alpha = 1.f; }
  else { mn = fmaxf(m_reg, pmax); alpha = __builtin_amdgcn_exp2f((m_reg - mn) * C); m_reg = mn; }
  const float mnC = -mn * C, Cq = C * rq;
#pragma unroll
  for (int r = 0; r < 16; ++r) p0[r] = fmaf(p0[r], Cq, mnC);
#pragma unroll
  for (int r = 0; r < 16; ++r) p1[r] = fmaf(p1[r], Cq, mnC);
#pragma unroll
  for (int r = 0; r < 16; ++r) p0[r] = __builtin_amdgcn_exp2f(p0[r]);
}
__device__ __forceinline__ void finishSM(f32x16& p0, f32x16& p1, float alpha, float& l_reg, bf16x8& pa0, bf16x8& pa1, bf16x8& pa2, bf16x8& pa3) {
#pragma unroll
  for (int r = 0; r < 16; ++r) p1[r] = __builtin_amdgcn_exp2f(p1[r]);
  float ps = 0;
#pragma unroll
  for (int r = 0; r < 16; ++r) ps += p0[r];
#pragma unroll
  for (int r = 0; r < 16; ++r) ps += p1[r];
  { auto rr = __builtin_amdgcn_permlane32_swap(__float_as_uint(ps), __float_as_uint(ps), false, false);
    ps = __uint_as_float(rr[0]) + __uint_as_float(rr[1]); }
  l_reg = l_reg * alpha + ps;
#define PK4(P, BASE, OUT) do { unsigned a0 = cvtpk(P[BASE + 0], P[BASE + 1]), a1 = cvtpk(P[BASE + 2], P[BASE + 3]);   \
    unsigned b0 = cvtpk(P[BASE + 4], P[BASE + 5]), b1 = cvtpk(P[BASE + 6], P[BASE + 7]);                              \
    auto r0 = __builtin_amdgcn_permlane32_swap(a0, b0, false, false); auto r1 = __builtin_amdgcn_permlane32_swap(a1, b1, false, false); \
    u32x4 w = {r0[0], r1[0], r0[1], r1[1]}; OUT = *reinterpret_cast<bf16x8*>(&w); } while (0)
  PK4(p0, 0, pa0); PK4(p0, 8, pa1); PK4(p1, 0, pa2); PK4(p1, 8, pa3);
#undef PK4
}
__device__ __forceinline__ void qkt(f32x16& p0, f32x16& p1, const char* Kb, const bf16x8* qr, int an, int tn, int ap, int tp) {
  p0 = f32x16{}; p1 = f32x16{};
#pragma unroll
  for (int d0 = 0; d0 < 8; ++d0) { const int o = an + (((2 * d0) ^ tn) << 4);
    bf16x8 b0 = *reinterpret_cast<const bf16x8*>(Kb + o);
    bf16x8 b1 = *reinterpret_cast<const bf16x8*>(Kb + o + 32 * 256);
    p0 = __builtin_amdgcn_mfma_f32_32x32x16_bf16(b0, qr[d0], p0, 0, 0, 0);
    p1 = __builtin_amdgcn_mfma_f32_32x32x16_bf16(b1, qr[d0], p1, 0, 0, 0); }
#pragma unroll
  for (int d0 = 0; d0 < 4; ++d0) { const int o = ap + (((2 * d0) ^ tp) << 4);
    bf16x8 b0 = *reinterpret_cast<const bf16x8*>(Kb + o);
    bf16x8 b1 = *reinterpret_cast<const bf16x8*>(Kb + o + 32 * 128);
    p0 = __builtin_amdgcn_mfma_f32_32x32x16_bf16(b0, qr[8 + d0], p0, 0, 0, 0);
    p1 = __builtin_amdgcn_mfma_f32_32x32x16_bf16(b1, qr[8 + d0], p1, 0, 0, 0); }
}
__device__ __forceinline__ int v_st(int k, int c) { const int kk = (k & ~0xC) | ((k & 4) << 1) | ((k & 8) >> 1); return ((kk >> 3) * 4 + (c >> 5)) * 512 + ((kk & 7) * 32 + (c & 31)) * 2; }
__device__ __forceinline__ int v_rd_base(int lane) { return ((lane & 3) << 3) | (((lane >> 2) & 3) << 6) | (((lane >> 4) & 1) << 5) | (((lane >> 5) & 1) << 8); }
constexpr int v_rd_off(int d0, int ks, int half) { return d0 * 512 + ks * 4096 + half * 2048; }
template <int OFF> __device__ __forceinline__ s16x4 tr_read(int vb) {
  s16x4 r; asm volatile("ds_read_b64_tr_b16 %0, %1 offset:%2" : "=&v"(r) : "v"(vb), "i"(OFF) : "memory"); return r;
}
template <int D0> __device__ __forceinline__ void pv_one(f32x16& od, int vb, bf16x8 pa0, bf16x8 pa1, bf16x8 pa2, bf16x8 pa3) {
  const s16x4 l0 = tr_read<v_rd_off(D0, 0, 0)>(vb), h0 = tr_read<v_rd_off(D0, 0, 1)>(vb), l1 = tr_read<v_rd_off(D0, 1, 0)>(vb), h1 = tr_read<v_rd_off(D0, 1, 1)>(vb);
  const s16x4 l2 = tr_read<v_rd_off(D0, 2, 0)>(vb), h2 = tr_read<v_rd_off(D0, 2, 1)>(vb), l3 = tr_read<v_rd_off(D0, 3, 0)>(vb), h3 = tr_read<v_rd_off(D0, 3, 1)>(vb);
  asm volatile("s_waitcnt lgkmcnt(0)" ::: "memory"); SBAR();
#define PK(L, H) (bf16x8){L[0], L[1], L[2], L[3], H[0], H[1], H[2], H[3]}
  od = __builtin_amdgcn_mfma_f32_32x32x16_bf16(pa0, PK(l0, h0), od, 0, 0, 0);
  od = __builtin_amdgcn_mfma_f32_32x32x16_bf16(pa1, PK(l1, h1), od, 0, 0, 0);
  od = __builtin_amdgcn_mfma_f32_32x32x16_bf16(pa2, PK(l2, h2), od, 0, 0, 0);
  od = __builtin_amdgcn_mfma_f32_32x32x16_bf16(pa3, PK(l3, h3), od, 0, 0, 0);
#undef PK
}
__device__ __forceinline__ void pv_d0(f32x16* o, int vb, bf16x8 pa0, bf16x8 pa1, bf16x8 pa2, bf16x8 pa3) {
  pv_one<0>(o[0], vb, pa0, pa1, pa2, pa3); pv_one<1>(o[1], vb, pa0, pa1, pa2, pa3); pv_one<2>(o[2], vb, pa0, pa1, pa2, pa3); pv_one<3>(o[3], vb, pa0, pa1, pa2, pa3);
}

__device__ __forceinline__ int v_src(int p, int l) { const int sub = 2 * p + (l >> 5), wq = l & 31, kk = (sub >> 2) * 8 + (wq >> 2), c = (sub & 3) * 32 + (wq & 3) * 8, k = (kk & ~0xC) | ((kk & 4) << 1) | ((kk & 8) >> 1); return k * 2048 + 128 + c; }
__device__ __forceinline__ void attn_unit(const bf16_t* __restrict__ Qb, const bf16_t* __restrict__ KVh, const bf16_t* __restrict__ KPb,
                                          const bf16_t* __restrict__ SGb, bf16_t* __restrict__ OGb, const float* __restrict__ ssqq, char* lds, LAS unsigned char* ldsl) {
  constexpr int LDQ = 1536, LDK = 2048, seq = SEQ;
  int tid_o = threadIdx.x; asm volatile("" : "+v"(tid_o));
  const int tid = tid_o, wid = __builtin_amdgcn_readfirstlane(tid >> 6), lane = tid & 63, r32 = lane & 31, hi = lane >> 5;
  float* ws = (float*)(lds + LDS_WS) + wid * 64; float* li_l = ws; float* al_l = ws + 32;
  float m_reg = -1e30f, l_reg = 0; f32x16 o[4] = {}; bf16x8 qr[12];
  const float rq = __builtin_amdgcn_rsqf(ssqq[wid * QBLK + r32] * (1.f / 384.f) + RMS_EPS);
  const bf16_t* Qw = Qb + (long)(wid * QBLK + r32) * LDQ + hi * 8;
#pragma unroll
  for (int d0 = 0; d0 < 12; ++d0) qr[d0] = *reinterpret_cast<const bf16x8*>(Qw + d0 * 16);
  int on0, on1, opp, ov0, ov1;
  { const int r0 = 8 * wid + (lane >> 4), r1 = r0 + 4, c16 = lane & 15;
    on0 = r0 * LDK + ((c16 ^ (r0 & 7)) << 3); on1 = r1 * LDK + ((c16 ^ (r1 & 7)) << 3);
    const int rp = 8 * wid + (lane >> 3), c8 = lane & 7; opp = rp * 64 + ((c8 ^ ((rp >> 1) & 7)) << 3);
    ov0 = v_src(2 * wid, lane); ov1 = v_src(2 * wid + 1, lane);
  }
  const int an = r32 * 256, tn = hi ^ (r32 & 7), ap = BUF_KP + r32 * 128, tp = hi ^ ((r32 >> 1) & 7);
  const int vrd = BUF_V + v_rd_base(lane);
  const int ldsb = (int)(uintptr_t)lds;
#define DMA1(gp_, off_) __builtin_amdgcn_global_load_lds((const unsigned*)(gp_), (LAS unsigned*)(ldsl + (off_)), 16, 0, 0)
#define DMA_TILE(k0, bo) do { const bf16_t* kb_ = KVh + (size_t)(k0) * LDK; const bf16_t* pb_ = KPb + (size_t)(k0) * 64; const int bw_ = (bo); \
    DMA1(kb_ + on0, bw_ + BUF_KN + wid * 2048); DMA1(kb_ + on1, bw_ + BUF_KN + wid * 2048 + 1024); DMA1(pb_ + opp, bw_ + BUF_KP + wid * 1024); \
    DMA1(kb_ + ov0, bw_ + BUF_V + wid * 2048); DMA1(kb_ + ov1, bw_ + BUF_V + wid * 2048 + 1024); } while (0)
#define WAITBAR(N) do { asm volatile("s_waitcnt vmcnt(" #N ")\n\ts_barrier" ::: "memory"); SBAR(); } while (0)
#define RESC(a) do { if (__any((a) < 1.f)) { if (hi == 0) al_l[r32] = (a); asm volatile("s_waitcnt lgkmcnt(0)" ::: "memory"); \
    _Pragma("unroll") for (int d = 0; d < 4; ++d) _Pragma("unroll") for (int r = 0; r < 16; ++r) o[d][r] *= al_l[crow(r, hi)]; } } while (0)
  f32x16 pA0, pA1, pB0, pB1; float mnA, mnB, alA, alB; bf16x8 pa0, pa1, pa2, pa3; constexpr int NT = seq / KVBLK;
  int bprv = 0, bcur = BUF_BYTES, bnxt = 2 * BUF_BYTES;
  DMA_TILE(0, 0); DMA_TILE(KVBLK, BUF_BYTES);
  WAITBAR(5);
  qkt(pA0, pA1, lds, qr, an, tn, ap, tp); partialSM(pA0, pA1, m_reg, mnA, alA, rq);
  WAITBAR(0);
  DMA_TILE(2 * KVBLK, 2 * BUF_BYTES);
#define STEP(P0_, P1_, mnP, alP, Q0_, Q1_, alQ, t_) do { \
    SBAR(); qkt(P0_, P1_, lds + bcur, qr, an, tn, ap, tp); \
    finishSM(Q0_, Q1_, alQ, l_reg, pa0, pa1, pa2, pa3); SBAR(); \
    pv_d0(o, ldsb + bprv + vrd, pa0, pa1, pa2, pa3); partialSM(P0_, P1_, m_reg, mnP, alP, rq); \
    RESC(alP); \
    WAITBAR(0);                                                      \
    if ((t_) + 2 < NT) DMA_TILE(((t_) + 2) * KVBLK, bprv); \
    { const int x_ = bprv; bprv = bcur; bcur = bnxt; bnxt = x_; } } while (0)
  for (int j = 1; j + 1 < NT; j += 2) {
    STEP(pB0, pB1, mnB, alB, pA0, pA1, alA, j);
    STEP(pA0, pA1, mnA, alA, pB0, pB1, alB, j + 1);
  }
  SBAR(); qkt(pB0, pB1, lds + bcur, qr, an, tn, ap, tp);
  finishSM(pA0, pA1, alA, l_reg, pa0, pa1, pa2, pa3); SBAR();
  pv_d0(o, ldsb + bprv + vrd, pa0, pa1, pa2, pa3); partialSM(pB0, pB1, m_reg, mnB, alB, rq);
  RESC(alB);
  finishSM(pB0, pB1, alB, l_reg, pa0, pa1, pa2, pa3); SBAR();
  pv_d0(o, ldsb + bcur + vrd, pa0, pa1, pa2, pa3);
  if (hi == 0) li_l[r32] = l_reg; asm volatile("s_waitcnt lgkmcnt(0)" ::: "memory");
  __syncthreads();
  int tid2 = tid; asm volatile("" : "+v"(tid2));
  const int wid2 = tid2 >> 6, lane2 = tid2 & 63;
  char* ost = lds + wid2 * 8704;
#pragma unroll
  for (int r = 0; r < 16; ++r) { const int orow = crow(r, hi); const float rl = __builtin_amdgcn_rcpf(li_l[orow]);
#pragma unroll
    for (int d0 = 0; d0 < 4; ++d0) *(bf16_t*)(ost + orow * 272 + (d0 * 32 + r32) * 2) = f2bf(o[d0][r] * rl); }
  asm volatile("s_waitcnt lgkmcnt(0)" ::: "memory");
  const int wrow = wid2 * QBLK;
#pragma unroll 2
  for (int k = 0; k < 8; ++k) { const int p = lane2 + 64 * k, row = p >> 4, pc = p & 15; const int idx = (wrow + row) * 1024 + pc * 8;
    const u32x4 ov = *(const u32x4*)(ost + row * 272 + pc * 16); const u32x4 sg = *(const u32x4*)(SGb + idx);
    u32x4 w; w.x = cvtpk(bflo(ov.x) * bflo(sg.x), bfhi(ov.x) * bfhi(sg.x)); w.y = cvtpk(bflo(ov.y) * bflo(sg.y), bfhi(ov.y) * bfhi(sg.y));
    w.z = cvtpk(bflo(ov.z) * bflo(sg.z), bfhi(ov.z) * bfhi(sg.z)); w.w = cvtpk(bflo(ov.w) * bflo(sg.w), bfhi(ov.w) * bfhi(sg.w));
    *(u32x4*)(OGb + idx) = w; }
  __syncthreads();
#undef DMA1
#undef DMA_TILE
#undef WAITBAR
#undef STEP
#undef RESC
}
}

namespace hy {
constexpr int GENW_BYTES = 4608;
constexpr int BPITCH = 528;
constexpr int BS_BYTES = 32 * BPITCH;
constexpr int LDS_GEN = 0, LDS_BS = 8 * GENW_BYTES;
constexpr int LDS_TOTAL = LDS_BS + 2 * BS_BYTES;
constexpr int EPITCH_W = 32 * 536;
__device__ __forceinline__ int crow(int r, int hi) { return (r & 3) + 8 * (r >> 2) + 4 * hi; }

template <bool SC>
__device__ __forceinline__ void conv_channel(const bf16_t* __restrict__ gen, const bf16_t* src, float w0, float w1, float w2, float cb,
                                             const bf16_t* __restrict__ mul, float mw0, float mw1, float mw2, float mb, bf16_t* dst, char* lds, bool do_epi = true) {
  int tid = threadIdx.x; asm volatile("" : "+v"(tid));
  const int wid = __builtin_amdgcn_readfirstlane(tid >> 6), lane = tid & 63, n32 = lane & 31, g = lane >> 5;
  char* genl = lds + LDS_GEN + wid * GENW_BYTES;
  { const bf16_t* gs = gen + (1792 - 256 * wid);
#pragma unroll
    for (int k = 0; k < 5; ++k) { const int pi = lane + 64 * k; if (pi < 288) *(u32x4*)(genl + pi * 16) = *(const u32x4*)(gs + pi * 8); } }
  const int sn = tid >> 4, sp = tid & 15;
  const int soff = sn * SEQ + sp * 8;
  u32x4 st_v[2]; unsigned short st_prev[2] = {0, 0}, st_next[2] = {0, 0};
#define CLOAD(ch) do { _Pragma("unroll") for (int h_ = 0; h_ < 2; ++h_) { const int s0_ = (ch) * 256 + h_ * 128 + sp * 8; st_v[h_] = *(const u32x4*)(src + soff + (ch) * 256 + h_ * 128); \
    if (SC) { st_prev[h_] = (s0_ > 0) ? src[soff + (ch) * 256 + h_ * 128 - 1] : (unsigned short)0; st_next[h_] = (s0_ + 8 < SEQ) ? src[soff + (ch) * 256 + h_ * 128 + 8] : (unsigned short)0; } } } while (0)
#define CWRITE(buf) do { _Pragma("unroll") for (int h_ = 0; h_ < 2; ++h_) { u32x4 w_ = st_v[h_]; if (SC) { float p_[10]; p_[0] = bf2f(st_prev[h_]); p_[9] = bf2f(st_next[h_]); \
      p_[1] = bflo(w_.x); p_[2] = bfhi(w_.x); p_[3] = bflo(w_.y); p_[4] = bfhi(w_.y); p_[5] = bflo(w_.z); p_[6] = bfhi(w_.z); p_[7] = bflo(w_.w); p_[8] = bfhi(w_.w); \
      float o_[8]; _Pragma("unroll") for (int k_ = 0; k_ < 8; ++k_) o_[k_] = fmaf(w0, p_[k_], fmaf(w1, p_[k_ + 1], fmaf(w2, p_[k_ + 2], cb))); \
      w_.x = cvtpk(o_[0], o_[1]); w_.y = cvtpk(o_[2], o_[3]); w_.z = cvtpk(o_[4], o_[5]); w_.w = cvtpk(o_[6], o_[7]); } \
    *(u32x4*)(lds + LDS_BS + (buf) * BS_BYTES + sn * BPITCH + h_ * 256 + sp * 16) = w_; } } while (0)
#ifndef CONV_REP_MAIN
#define CONV_REP_MAIN 1
#endif
  f32x16 acc[8];
  for (int rep_ = 0; rep_ < CONV_REP_MAIN; ++rep_) {
  CLOAD(0); CWRITE(0);
  const int e_l = 255 + 8 * g - n32;
  const char* abase = genl + ((e_l & ~1) * 2);
  const unsigned ash = (unsigned)(e_l & 1) * 16u;
#define AFRAG(dst_, dprime) do { const unsigned* ap_ = (const unsigned*)(abase + (dprime) * 2); \
    const unsigned d0_ = ap_[0], d1_ = ap_[1], d2_ = ap_[2], d3_ = ap_[3], d4_ = ap_[4]; \
    u32x4 f_; f_.x = __builtin_amdgcn_alignbit(d1_, d0_, ash); f_.y = __builtin_amdgcn_alignbit(d2_, d1_, ash); f_.z = __builtin_amdgcn_alignbit(d3_, d2_, ash); f_.w = __builtin_amdgcn_alignbit(d4_, d3_, ash); \
    dst_ = __builtin_bit_cast(bf16x8, f_); } while (0)
#pragma unroll
  for (int m = 0; m < 8; ++m) acc[m] = f32x16{};
  bf16x8 ring[8][2];
  __syncthreads();
#pragma unroll
  for (int q = 1; q < 8; ++q) { AFRAG(ring[q][0], 32 * (q - 8)); AFRAG(ring[q][1], 32 * (q - 8) + 16); }
  const char* bbase = lds + LDS_BS + n32 * BPITCH + g * 16;
  for (int it8 = 0; it8 < 8; ++it8) {
    if (it8 + 1 < 8) CLOAD(it8 + 1);
    __builtin_amdgcn_sched_barrier(0);
    const char* bb = bbase + (it8 & 1) * BS_BYTES;
#pragma unroll
    for (int ii = 0; ii < 8; ++ii) {
      const int dp = 32 * (it8 * 8 + ii);
      AFRAG(ring[ii][0], dp); AFRAG(ring[ii][1], dp + 16);
      const bf16x8 b0 = *(const bf16x8*)(bb + ii * 64), b1 = *(const bf16x8*)(bb + ii * 64 + 32);
#pragma unroll
      for (int m = 0; m < 8; ++m) {
        acc[m] = __builtin_amdgcn_mfma_f32_32x32x16_bf16(ring[(ii - m) & 7][0], b0, acc[m], 0, 0, 0);
        acc[m] = __builtin_amdgcn_mfma_f32_32x32x16_bf16(ring[(ii - m) & 7][1], b1, acc[m], 0, 0, 0);
      }
    }
    if (it8 + 1 < 8) CWRITE((it8 + 1) & 1);
    __syncthreads();
  }
  }
  if (!do_epi) return;
  int tid2 = tid; asm volatile("" : "+v"(tid2));
  const int wid2 = __builtin_amdgcn_readfirstlane(tid2 >> 6), lane2 = tid2 & 63, n2 = lane2 & 31, g2 = lane2 >> 5;
  char* et = lds + wid2 * EPITCH_W;
  const int tw0 = 256 * wid2;
  { u32x4 rv[16];
#pragma unroll
    for (int k = 0; k < 16; ++k) { const int pi = lane2 + 64 * k, rn = pi >> 5, pp = pi & 31; rv[k] = *(const u32x4*)(mul + rn * SEQ + tw0 + pp * 8); }
    unsigned short hv = 0;
    if (g2 == 0) { if (tw0 > 0) hv = mul[n2 * SEQ + tw0 - 1]; } else { if (tw0 + 256 < SEQ) hv = mul[n2 * SEQ + tw0 + 256]; }
#pragma unroll
    for (int k = 0; k < 16; ++k) { const int pi = lane2 + 64 * k, rn = pi >> 5, pp = pi & 31; u32x2* d = (u32x2*)(et + rn * 536 + 8 + pp * 16); d[0] = (u32x2){rv[k].x, rv[k].y}; d[1] = (u32x2){rv[k].z, rv[k].w}; }
    *(unsigned short*)(et + n2 * 536 + (g2 ? 520 : 6)) = hv; }
  asm volatile("s_waitcnt lgkmcnt(0)" ::: "memory");
#pragma unroll
  for (int m = 0; m < 8; ++m)
#pragma unroll
    for (int q = 0; q < 4; ++q) {
      const int tl = 32 * m + 8 * q + 4 * g2;
      char* ep = et + n2 * 536 + 8 + tl * 2;
      const u32x2 pv = *(const u32x2*)ep;
      const float pm1 = bf2f(*(const unsigned short*)(ep - 2)), pp4 = bf2f(*(const unsigned short*)(ep + 8));
      const float p0 = bflo(pv.x), p1 = bfhi(pv.x), p2 = bflo(pv.y), p3 = bfhi(pv.y);
      const float x0 = fmaf(mw0, pm1, fmaf(mw1, p0, fmaf(mw2, p1, mb))), x1 = fmaf(mw0, p0, fmaf(mw1, p1, fmaf(mw2, p2, mb)));
      const float x2 = fmaf(mw0, p1, fmaf(mw1, p2, fmaf(mw2, p3, mb))), x3 = fmaf(mw0, p2, fmaf(mw1, p3, fmaf(mw2, pp4, mb)));
#ifdef PROBE_ROUND_Y
      _Pragma("unroll") for (int e_ = 0; e_ < 4; ++e_) acc[m][4 * q + e_] = bf2f(f2bf(acc[m][4 * q + e_]));
#endif
      acc[m][4 * q + 0] *= x0; acc[m][4 * q + 1] *= x1; acc[m][4 * q + 2] *= x2; acc[m][4 * q + 3] *= x3;
    }
  asm volatile("s_waitcnt lgkmcnt(0)" ::: "memory");
#pragma unroll
  for (int m = 0; m < 8; ++m)
#pragma unroll
    for (int q = 0; q < 4; ++q) {
      const int tl = 32 * m + 8 * q + 4 * g2;
      u32x2 ov; ov.x = cvtpk(acc[m][4 * q + 0], acc[m][4 * q + 1]); ov.y = cvtpk(acc[m][4 * q + 2], acc[m][4 * q + 3]);
      *(u32x2*)(et + n2 * 536 + 8 + tl * 2) = ov;
    }
  asm volatile("s_waitcnt lgkmcnt(0)" ::: "memory");
#pragma unroll
  for (int k = 0; k < 16; ++k) { const int pi = lane2 + 64 * k, rn = pi >> 5, pp = pi & 31; const u32x2* d = (const u32x2*)(et + rn * 536 + 8 + pp * 16);
    const u32x2 a0 = d[0], a1 = d[1]; *(u32x4*)(dst + rn * SEQ + tw0 + pp * 8) = (u32x4){a0.x, a0.y, a1.x, a1.y}; }
  __syncthreads();
#undef CLOAD
#undef CWRITE
#undef AFRAG
}
}

#define XB_TMO      128
#define XB_XCNT(j)  (256  + 64 * (j))
#define XB_XSUB(j)  (1280 + 64 * (j))
#define XB_XGEN(j)  (2304 + 64 * (j))
#define XB_TOP      3328
#define XB_TOPGEN   3392
#define XCD_BAR_WORDS 3456
#define XB_SPIN_CAP (1u << 18)

__device__ __forceinline__ unsigned xb_ld(unsigned* p)              { return __hip_atomic_load(p, __ATOMIC_RELAXED, __HIP_MEMORY_SCOPE_AGENT); }
__device__ __forceinline__ unsigned xb_add(unsigned* p, unsigned v) { return __hip_atomic_fetch_add(p, v, __ATOMIC_RELAXED, __HIP_MEMORY_SCOPE_AGENT); }
__device__ __forceinline__ unsigned xb_xcc_id() { return (unsigned)__builtin_amdgcn_s_getreg((3 << 11) | 20) & 0xFu; }
#define XB_SPIN(cond, bar) do { unsigned _sp = 0; while (cond) { __builtin_amdgcn_s_sleep(1); \
    if ((++_sp & 255u) == 0u) { if (xb_ld(&(bar)[XB_TMO])) break; if (_sp > XB_SPIN_CAP) { atomicAdd(&(bar)[XB_TMO], 1u); break; } } } } while (0)

struct XcdBarrier {
    unsigned* bar; unsigned x;
    volatile LAS unsigned* st;
};

__device__ __forceinline__ XcdBarrier xcd_barrier_post(unsigned* bar, volatile LAS unsigned* st) {
    XcdBarrier b; b.bar = bar; b.x = xb_xcc_id(); b.st = st;
    if (threadIdx.x == 0) (void)xb_add(&bar[XB_XCNT(b.x)], 1u);
    return b;
}
__device__ __forceinline__ void xcd_barrier_complete(unsigned* bar, unsigned x, unsigned& nloc, unsigned& nx) {
    const unsigned G = gridDim.x * gridDim.y * gridDim.z;
    unsigned sum, cnt, mine, sp = 0u;
    for (;;) {
        sum = 0u; cnt = 0u; mine = 0u;
#pragma unroll
        for (unsigned j = 0; j < 16; ++j) { const unsigned c = xb_ld(&bar[XB_XCNT(j)]); sum += c; cnt += (c > 0u) ? 1u : 0u; mine = (j == x) ? c : mine; }
        if (sum == G) break;
        __builtin_amdgcn_s_sleep(1);
        if ((++sp & 255u) == 0u) { if (xb_ld(&bar[XB_TMO])) break; if (sp > XB_SPIN_CAP) { atomicAdd(&bar[XB_TMO], 1u); break; } }
    }
    nloc = mine > 0u ? mine : 1u; nx = cnt > 0u ? cnt : 1u;
}

__device__ __forceinline__ void xcd_barrier(const XcdBarrier& b) {
    asm volatile("s_waitcnt vmcnt(0)" ::: "memory");
    __syncthreads();
    if (threadIdx.x == 0) {
        unsigned* bar = b.bar;
        __builtin_amdgcn_s_waitcnt(0);
        unsigned nloc = b.st[0], nx = b.st[1];
        if (nloc == 0u) { xcd_barrier_complete(bar, b.x, nloc, nx); b.st[0] = nloc; b.st[1] = nx; }
        const unsigned old = xb_add(&bar[XB_XSUB(b.x)], 1u);
        const unsigned gen = old / nloc;
        if (old + 1u == (gen + 1u) * nloc) {
            __builtin_amdgcn_fence(__ATOMIC_RELEASE, "agent");
            asm volatile("s_waitcnt vmcnt(0)" ::: "memory");
            const unsigned og = xb_add(&bar[XB_TOP], 1u);
            const unsigned tg = og / nx;
            if (og + 1u == (tg + 1u) * nx) xb_add(&bar[XB_TOPGEN], 1u);
            else XB_SPIN(xb_ld(&bar[XB_TOPGEN]) == tg, bar);
            __builtin_amdgcn_fence(__ATOMIC_ACQUIRE, "agent");
            xb_add(&bar[XB_XGEN(b.x)], 1u);
            asm volatile("s_waitcnt vmcnt(0)" ::: "memory");
        } else {
            XB_SPIN(xb_ld(&bar[XB_XGEN(b.x)]) == gen, bar);
            __builtin_amdgcn_fence(__ATOMIC_ACQUIRE, "agent");
            asm volatile("s_waitcnt vmcnt(0)" ::: "memory");
        }
    }
    __syncthreads();
}

#ifndef PH_MASK
#define PH_MASK 0xFFFF
#endif
#define PH(n) (((PH_MASK) >> (n)) & 1)
#ifndef REP_MASK
#define REP_MASK 0
#endif
#define NREP(n) (1 + (((REP_MASK) >> (n)) & 1))
struct Args { const float* in[23]; float* out; unsigned char* ws; };

enum { I_X = 0, I_L0N, I_L0WIN, I_L0QN, I_L0WUQ, I_L0KVN, I_L0WUKV, I_L0WOUT, I_L1N, I_L1WIN, I_L1CW, I_L1CB, I_FW1, I_FB1, I_FW2, I_FB2, I_FW3, I_FB3, I_FW4, I_FFREQ, I_FBIAS, I_L1WOUT, I_FN };

__device__ __forceinline__ int wmap(int which, int n) {
    if (which == 0) {
        if (n < 640) return n;
        if (n < 704) { const int s = n - 640, q = s >> 3, e = s & 7; return 640 + ((e < 4) ? (4 * q + e) : (32 + 4 * q + (e - 4))); }
        if (n < 768) return -1;
        return n - 64;
    }
    if (which == 1) {
        const int h = n / 192, j = n % 192;
        if (j < 128) return n;
        const int s = j - 128, q = s >> 3, e = s & 7; return h * 192 + 128 + ((e < 4) ? (4 * q + e) : (32 + 4 * q + (e - 4)));
    }
    return n;
}
__device__ __forceinline__ void transpose_item(const float* __restrict__ W, int K, int Nsrc, int Ndst, bf16_t* __restrict__ WT, int which, float* scr, int item, int lane, const float* __restrict__ kgain = nullptr) {
    const int nblk = Ndst / 32, kb = item / nblk, nb = item % nblk, k0 = 64 * kb, n0 = 32 * nb;
    const int sc = wmap(which, n0 + (lane & 31));
#pragma unroll 8
    for (int i = 0; i < 32; ++i) { const int kk = 2 * i + (lane >> 5); const float gk = kgain ? kgain[k0 + kk] : 1.f; scr[kk * 33 + (lane & 31)] = (sc >= 0) ? W[(size_t)(k0 + kk) * Nsrc + sc] * gk : 0.f; }
    asm volatile("s_waitcnt lgkmcnt(0)" ::: "memory");
    const int c = lane & 7;
#pragma unroll
    for (int j = 0; j < 4; ++j) { const int n = (lane >> 3) + 8 * j; const float* s = scr + (8 * c) * 33 + n;
        u32x4 o; o.x = cvtpk(s[0 * 33], s[1 * 33]); o.y = cvtpk(s[2 * 33], s[3 * 33]); o.z = cvtpk(s[4 * 33], s[5 * 33]); o.w = cvtpk(s[6 * 33], s[7 * 33]);
        *(u32x4*)(WT + (size_t)(n0 + n) * K + k0 + 8 * c) = o; }
    asm volatile("s_waitcnt lgkmcnt(0)" ::: "memory");
}
template <bool TO_BF16>
__device__ __forceinline__ void rms_rows4(const float* xrow, const float* __restrict__ gain, void* orow, int lane) {
    f32x4 v[4][4]; float s[4];
#pragma unroll
    for (int r = 0; r < 4; ++r)
#pragma unroll
        for (int j = 0; j < 4; ++j) v[r][j] = ((const f32x4*)(xrow + r * 1024) + lane)[64 * j];
#pragma unroll
    for (int r = 0; r < 4; ++r) { s[r] = 0.f;
#pragma unroll
        for (int j = 0; j < 4; ++j) s[r] += (v[r][j].x * v[r][j].x + v[r][j].y * v[r][j].y) + (v[r][j].z * v[r][j].z + v[r][j].w * v[r][j].w); }
#pragma unroll
    for (int o = 1; o < 64; o <<= 1) {
#pragma unroll
        for (int r = 0; r < 4; ++r) s[r] += __shfl_xor(s[r], o); }
    f32x4 gg[4];
#pragma unroll
    for (int j = 0; j < 4; ++j) gg[j] = ((const f32x4*)gain + lane)[64 * j];
#pragma unroll
    for (int r = 0; r < 4; ++r) { const float rinv = 1.f / sqrtf(s[r] * (1.f / 1024.f) + RMS_EPS);
#pragma unroll
        for (int j = 0; j < 4; ++j) { const f32x4 y = v[r][j] * rinv * gg[j];
            if (TO_BF16) { u32x2 w; w.x = cvtpk(y.x, y.y); w.y = cvtpk(y.z, y.w); ((u32x2*)((bf16_t*)orow + r * 1024) + lane)[64 * j] = w; }
            else ((f32x4*)((float*)orow + r * 1024) + lane)[64 * j] = y; } }
}

__device__ __forceinline__ void filter_item(const Args& A, int t0, bf16_t* __restrict__ gen, float* sm) {
    const int tid = threadIdx.x;
    float* z = sm;
    float* a = sm + 288;
    float* b = sm + 288 + 512;
    const float* w1 = A.in[I_FW1]; const float* b1 = A.in[I_FB1]; const float* w2 = A.in[I_FW2]; const float* b2 = A.in[I_FB2];
    const float* w3 = A.in[I_FW3]; const float* b3 = A.in[I_FB3]; const float* w4 = A.in[I_FW4]; const float* fr = A.in[I_FFREQ]; const float* fbias = A.in[I_FBIAS];
    __syncthreads();
    { const int tt = tid >> 6, j = tid & 63; const int t = t0 + tt;
      if (j < 33) { float v;
        if (j == 0) v = (float)t * (1.f / 2047.f);
        else { const int bi = (j - 1) & 15; const float bandv = 1e-4f + (15.f - 1e-4f) * ((float)bi / 15.f);
               const float w = 6.283185307179586f * (float)t * (1.f / 2048.f); float s, c; sincos_cw(w * bandv, s, c); v = (j <= 16) ? c : -s; }
        z[tt * 36 + j] = v; } }
    __syncthreads();
    const int tt = tid >> 6, o = tid & 63; const float fo = fr[o];
    { float s = b1[o];
#pragma unroll 3
      for (int j = 0; j < 33; ++j) s = fmaf(z[tt * 36 + j], w1[j * 64 + o], s);
      a[tt * 64 + o] = sin_cw(fo * s); }
    __syncthreads();
    { float s = b2[o];
#pragma unroll 8
      for (int j = 0; j < 64; ++j) s = fmaf(a[tt * 64 + j], w2[j * 64 + o], s);
      b[tt * 64 + o] = sin_cw(fo * s); }
    __syncthreads();
    { float s = b3[o];
#pragma unroll 8
      for (int j = 0; j < 64; ++j) s = fmaf(b[tt * 64 + j], w3[j * 64 + o], s);
      a[tt * 64 + o] = sin_cw(fo * s); }
    __syncthreads();
    for (int i = 0; i < 8; ++i) {
        const int col = tid + 512 * i; const int n = col >> 11, dir = (col >> 10) & 1, c = col & 1023;
        float acc[8];
#pragma unroll
        for (int q = 0; q < 8; ++q) acc[q] = 0.f;
#pragma unroll 2
        for (int k = 0; k < 64; k += 4) { const float w0 = w4[k * 4096 + col], w1 = w4[(k + 1) * 4096 + col], w2 = w4[(k + 2) * 4096 + col], w3 = w4[(k + 3) * 4096 + col];
#pragma unroll
            for (int q = 0; q < 8; ++q) { const f32x4 av = *(const f32x4*)(a + q * 64 + k);
                acc[q] = fmaf(av.x, w0, acc[q]); acc[q] = fmaf(av.y, w1, acc[q]); acc[q] = fmaf(av.z, w2, acc[q]); acc[q] = fmaf(av.w, w3, acc[q]); } }
        const float delta = fabsf(-3.0701134573253945f + (-15.350567286626973f + 3.0701134573253945f) * ((float)c * (1.f / 1023.f)));
        bf16_t* gr = gen + ((size_t)(n * 1024 + c)) * 4096;
#pragma unroll
        for (int q = 0; q < 8; ++q) { const int t = t0 + q; const float tv = (float)t * (1.f / 2047.f);
            float v = acc[q] * __builtin_amdgcn_exp2f(-1.4426950408889634f * tv * delta);
            if (dir == 0) { if (t == 0) v += fbias[n * 1024 + c]; gr[2047 - t] = f2bf(v); }
            else if (t > 0) gr[2047 + t] = f2bf(v); }
        if (t0 == 0 && dir == 1) gr[4095] = 0;
    }
}

__global__ void __launch_bounds__(512) fwd_megakernel(Args A) {
    extern __shared__ __attribute__((aligned(16))) unsigned char lds[];
    cg::grid_group grid = cg::this_grid();
    const int G = gridDim.x, bx = blockIdx.x, NGW = G * 8;
#define PHASE_IDS int tid = threadIdx.x; asm volatile("" : "+v"(tid)); const int lane = tid & 63, wave = __builtin_amdgcn_readfirstlane(tid >> 6), gw = bx * 8 + wave; (void)lane; (void)gw;
    unsigned char* ws = A.ws;
    bf16_t* W0t = (bf16_t*)(ws + WS_W0); bf16_t* Wuqt = (bf16_t*)(ws + WS_WUQ); bf16_t* Wukvt = (bf16_t*)(ws + WS_WUKV);
    bf16_t* Wo0t = (bf16_t*)(ws + WS_WO0); bf16_t* W1t = (bf16_t*)(ws + WS_W1); bf16_t* Wo1t = (bf16_t*)(ws + WS_WO1);
    float* rope = (float*)(ws + WS_ROPE); bf16_t* gen = (bf16_t*)(ws + WS_GEN);
    bf16_t* R1 = (bf16_t*)(ws + WS_R1); bf16_t* R2 = (bf16_t*)(ws + WS_R2);
    float* ssq = (float*)(ws + WS_SSQ); bf16_t* HB = (bf16_t*)(ws + WS_HB); bf16_t* cqn = (bf16_t*)(ws + WS_CQN); bf16_t* ckvn = (bf16_t*)(ws + WS_CKVN);
    bf16_t* kpe = (bf16_t*)(ws + WS_KPE); bf16_t* Qb = (bf16_t*)(ws + WS_Q); bf16_t* KV = (bf16_t*)(ws + WS_KV);
    bf16_t* UT = (bf16_t*)(ws + WS_UT); bf16_t* ZG = (bf16_t*)(ws + WS_ZG);
    LAS unsigned char* ldsl = (LAS unsigned char*)lds;
    volatile LAS unsigned* bst = (volatile LAS unsigned*)(ldsl + LDS_BYTES - 64);
    if (threadIdx.x < 2) bst[threadIdx.x] = 0u;
    __syncthreads();
    const XcdBarrier xbar = xcd_barrier_post((unsigned*)(ws + WS_BAR), bst);

    if constexpr (PH(0)) for (int rep_ = 0; rep_ < NREP(0); ++rep_) {
        PHASE_IDS
        float* scr = (float*)(lds + wave * 16384);
        constexpr int I0 = 16 * 56, I1 = 6 * 48, I2 = 4 * 64, I3 = 16 * 32, I4 = 16 * 128, I5 = 16 * 32;
        for (int it = gw; it < I0 + I1 + I2 + I3 + I4 + I5; it += NGW) {
            int r = it;
            if (r < I0) { transpose_item(A.in[I_L0WIN], 1024, 1728, 1792, W0t, 0, scr, r, lane); continue; } r -= I0;
            if (r < I1) { transpose_item(A.in[I_L0WUQ], 384, 1536, 1536, Wuqt, 1, scr, r, lane, A.in[I_L0QN]); continue; } r -= I1;
            if (r < I2) { transpose_item(A.in[I_L0WUKV], 256, 2048, 2048, Wukvt, 2, scr, r, lane, A.in[I_L0KVN]); continue; } r -= I2;
            if (r < I3) { transpose_item(A.in[I_L0WOUT], 1024, 1024, 1024, Wo0t, 2, scr, r, lane); continue; } r -= I3;
            if (r < I4) { transpose_item(A.in[I_L1WIN], 1024, 4096, 4096, W1t, 2, scr, r, lane, A.in[I_L1N]); continue; } r -= I4;
            transpose_item(A.in[I_L1WOUT], 1024, 1024, 1024, Wo1t, 2, scr, r, lane);
        }
        for (int i = bx * 512 + tid; i < 3 * NTOK; i += G * 512) ssq[i] = 0.f;
        for (int i = bx * 512 + tid; i < SEQ * 32; i += G * 512) {
            const int pos = i >> 5, j = i & 31; const float inv = __builtin_amdgcn_exp2f(-(float)j * (13.287712379549449f / 32.f));
            float s, c; sincos_cw((float)pos * inv, s, c); rope[i] = c; rope[SEQ * 32 + i] = s;
        }
        __syncthreads();
#ifndef P0_REP_F
#define P0_REP_F 1
#endif
#ifndef P0_REP_X
#define P0_REP_X 1
#endif
        for (int rf_ = 0; rf_ < P0_REP_F; ++rf_)
        for (int tg = bx; tg < SEQ / 8; tg += G) filter_item(A, tg * 8, gen, (float*)lds);
        for (int rx_ = 0; rx_ < P0_REP_X; ++rx_)
        for (int m = gw * 4; m < NTOK; m += NGW * 4) rms_rows4<true>(A.in[I_X] + (size_t)m * 1024, A.in[I_L0N], R1 + (size_t)m * 1024, lane);
    }
    xcd_barrier(xbar);
    if (A.ws == nullptr) grid.sync();
#ifdef EXTRA_SYNCS
    for (int i_ = 0; i_ < EXTRA_SYNCS; ++i_) grid.sync();
#endif
    if constexpr (PH(1)) for (int rep_ = 0; rep_ < NREP(1); ++rep_) {
        pg8::Gemm g{R1, W0t, NTOK, N0P, 1024}; pg8::StaticOrder S; S.init(NTOK, N0P, G, bx);
        EpiRows<F_G1> E{F_G1{cqn, ckvn, ssq, ssq + NTOK, kpe, R2, rope}};
        pg8::gemm_phase<EpiRows<F_G1>, pg8::StaticOrder, true, true>(ldsl, g, S, E);
    }
    xcd_barrier(xbar);
    if constexpr (PH(3)) for (int rep_ = 0; rep_ < NREP(3); ++rep_) {
        pg8::Gemm g{cqn, Wuqt, NTOK, 1536, 384}; pg8::StaticOrder S; S.init(NTOK, 1536, G, bx);
        EpiRows<F_G2Q> E{F_G2Q{Qb, rope}};
        pg8::gemm_phase<EpiRows<F_G2Q>, pg8::StaticOrder, true, true>(ldsl, g, S, E);
    }
    if constexpr (PH(4)) for (int rep_ = 0; rep_ < NREP(4); ++rep_) {
        pg8::Gemm g{ckvn, Wukvt, NTOK, 2048, 256}; pg8::StaticOrder S; S.init(NTOK, 2048, G, bx);
        EpiRows<F_G2KV> E{F_G2KV{KV, ssq + NTOK}};
        pg8::gemm_phase<EpiRows<F_G2KV>, pg8::StaticOrder, true, true>(ldsl, g, S, E);
    }
    xcd_barrier(xbar);
    if constexpr (PH(5)) for (int rep_ = 0; rep_ < NREP(5); ++rep_) {
        const int vcu = (G % 8 == 0) ? (bx % 8) * (G / 8) + bx / 8 : bx;
        for (int U = vcu; U < NB * NHEAD * 8; U += G) {
            const int qb = U & 7, bh = U >> 3, h = bh & 7, b = bh >> 3;
            const size_t row0 = (size_t)b * SEQ + qb * 256;
            att::attn_unit(Qb + row0 * 1536 + h * 192, KV + (size_t)b * SEQ * 2048 + h * 256, kpe + (size_t)b * SEQ * 64,
                           R2 + row0 * 1024 + h * 128, R1 + row0 * 1024 + h * 128, ssq + row0, (char*)lds, ldsl);
        }
    }
    xcd_barrier(xbar);
    if constexpr (PH(6)) for (int rep_ = 0; rep_ < NREP(6); ++rep_) {
        pg8::Gemm g{R1, Wo0t, NTOK, 1024, 1024}; pg8::StaticOrder S; S.init(NTOK, 1024, G, bx);
        EpiRows<F_RES1> E{F_RES1{A.in[I_X], A.out, HB, ssq + 2 * NTOK}};
        pg8::gemm_phase<EpiRows<F_RES1>, pg8::StaticOrder, true, true>(ldsl, g, S, E);
    }
    xcd_barrier(xbar);
    if constexpr (PH(8)) for (int rep_ = 0; rep_ < NREP(8); ++rep_) {
        pg8::Gemm g{W1t, HB, 3072, NTOK, 1024}; pg8::StaticOrder S; S.init(3072, NTOK, G, bx);
        EpiRows<F_UT> E{F_UT{UT, ssq + 2 * NTOK}};
        pg8::gemm_phase<EpiRows<F_UT>, pg8::StaticOrder, true, true>(ldsl, g, S, E);
    }
    if constexpr (PH(9)) for (int rep_ = 0; rep_ < NREP(9); ++rep_) {
        pg8::Gemm g{HB, W1t + (size_t)3072 * 1024, NTOK, 1024, 1024}; pg8::StaticOrder S; S.init(NTOK, 1024, G, bx);
        EpiRows<F_SILU1> E{F_SILU1{R2, ssq + 2 * NTOK}};
        pg8::gemm_phase<EpiRows<F_SILU1>, pg8::StaticOrder, true, true>(ldsl, g, S, E);
    }
    xcd_barrier(xbar);
    if constexpr (PH(10)) for (int rep_ = 0; rep_ < NREP(10); ++rep_) {
        const float* cw = A.in[I_L1CW]; const float* cbv = A.in[I_L1CB];
#ifndef CONV_PROBE_MAIN
#define CONV_PROBE_MAIN 0
#endif
        for (int c = bx; c < 1024; c += G) {
            const int cv = 2048 + c, c1 = c, c2 = 1024 + c;
            if (CONV_PROBE_MAIN) {
                hy::conv_channel<true>(gen + (size_t)c * 4096, UT + (size_t)cv * NTOK, cw[cv], cw[3072 + cv], cw[6144 + cv], cbv[cv],
                                       UT + (size_t)c1 * NTOK, cw[c1], cw[3072 + c1], cw[6144 + c1], cbv[c1], R1 + (size_t)c * NTOK, (char*)lds, false);
                hy::conv_channel<false>(gen + (size_t)(1024 + c) * 4096, UT + (size_t)cv * NTOK, 0.f, 0.f, 0.f, 0.f,
                                        UT + (size_t)c2 * NTOK, cw[c2], cw[3072 + c2], cw[6144 + c2], cbv[c2], ZG + (size_t)c * NTOK, (char*)lds, false);
            }
            hy::conv_channel<true>(gen + (size_t)c * 4096, UT + (size_t)cv * NTOK, cw[cv], cw[3072 + cv], cw[6144 + cv], cbv[cv],
                                   UT + (size_t)c1 * NTOK, cw[c1], cw[3072 + c1], cw[6144 + c1], cbv[c1], R1 + (size_t)c * NTOK, (char*)lds);
            __threadfence(); __syncthreads();
            hy::conv_channel<false>(gen + (size_t)(1024 + c) * 4096, R1 + (size_t)c * NTOK, 0.f, 0.f, 0.f, 0.f,
                                    UT + (size_t)c2 * NTOK, cw[c2], cw[3072 + c2], cw[6144 + c2], cbv[c2], ZG + (size_t)c * NTOK, (char*)lds);
        }
    }
    xcd_barrier(xbar);
    if constexpr (PH(11)) for (int rep_ = 0; rep_ < NREP(11); ++rep_) {
        PHASE_IDS
        bf16_t* tl = (bf16_t*)(lds + wave * 16384);
        for (int it = gw; it < 16 * 1024; it += NGW) {
            const int cb = it & 15, tb = it >> 4, c0 = cb * 64, tok0 = tb * 64;
#pragma unroll
            for (int k = 0; k < 8; ++k) { const int pi = lane + 64 * k, cc = pi >> 3, pc = pi & 7;
                *(u32x4*)(tl + cc * 72 + ((pc ^ k) << 3)) = *(const u32x4*)(ZG + (size_t)(c0 + cc) * NTOK + tok0 + pc * 8); }
            asm volatile("s_waitcnt lgkmcnt(0)" ::: "memory");
            const int j = lane >> 3, p = lane & 7;
#pragma unroll
            for (int t8 = 0; t8 < 8; ++t8) {
                const size_t rowo = (size_t)(tok0 + t8 * 8 + j) * 1024 + c0 + 8 * p;
                const u32x4 sgv = *(const u32x4*)(R2 + rowo);
                const bf16_t* tc = tl + (8 * p) * 72 + ((t8 ^ p) << 3) + j;
                float zv[8];
#pragma unroll
                for (int e = 0; e < 8; ++e) zv[e] = bf2f(tc[e * 72]);
                u32x4 o; o.x = cvtpk(zv[0] * bflo(sgv.x), zv[1] * bfhi(sgv.x)); o.y = cvtpk(zv[2] * bflo(sgv.y), zv[3] * bfhi(sgv.y));
                o.z = cvtpk(zv[4] * bflo(sgv.z), zv[5] * bfhi(sgv.z)); o.w = cvtpk(zv[6] * bflo(sgv.w), zv[7] * bfhi(sgv.w));
                *(u32x4*)(R1 + rowo) = o;
            }
            asm volatile("s_waitcnt lgkmcnt(0)" ::: "memory");
        }
    }
    xcd_barrier(xbar);
    if constexpr (PH(12)) for (int rep_ = 0; rep_ < NREP(12); ++rep_) {
        pg8::Gemm g{R1, Wo1t, NTOK, 1024, 1024}; pg8::StaticOrder S; S.init(NTOK, 1024, G, bx);
        EpiRows<F_RES> E{F_RES{A.out, A.out}};
        pg8::gemm_phase<EpiRows<F_RES>, pg8::StaticOrder, true, true>(ldsl, g, S, E);
    }
    xcd_barrier(xbar);
    if constexpr (PH(13)) for (int rep_ = 0; rep_ < NREP(13); ++rep_) { PHASE_IDS
        for (int m = gw * 4; m < NTOK; m += NGW * 4) rms_rows4<false>(A.out + (size_t)m * 1024, A.in[I_FN], A.out + (size_t)m * 1024, lane); }
}

extern "C" void kernel_launch(void* const* d_in, const int* in_sizes, int n_in, void* d_out, int out_size, void* d_ws, size_t ws_size, hipStream_t stream) {
    static int grid = 0;
    if (grid == 0) {
        if (n_in != 23 || in_sizes[0] != NTOK * DM || out_size != NTOK * DM || ws_size < WS_END) {
            fprintf(stderr, "kernel_launch: shape mismatch (n_in %d, in0 %d, out %d, ws %zu; need ws >= %zu)\n", n_in, n_in > 0 ? in_sizes[0] : -1, out_size, ws_size, (size_t)WS_END); grid = -1; return; }
        int dev = 0, cus = 0, per_cu = 0;
        hipGetDevice(&dev); hipDeviceGetAttribute(&cus, hipDeviceAttributeMultiprocessorCount, dev);
        if (hipFuncSetAttribute((const void*)fwd_megakernel, hipFuncAttributeMaxDynamicSharedMemorySize, LDS_BYTES) != hipSuccess) { fprintf(stderr, "kernel_launch: hipFuncSetAttribute failed\n"); grid = -1; return; }
        if (hipOccupancyMaxActiveBlocksPerMultiprocessor(&per_cu, (const void*)fwd_megakernel, 512, LDS_BYTES) != hipSuccess || per_cu < 1) { fprintf(stderr, "kernel_launch: occupancy query gave %d\n", per_cu); per_cu = 1; }
        (void)hipGetLastError();
        grid = cus * per_cu;
    }
    if (grid < 0) return;
    Args a{};
    for (int i = 0; i < 23; ++i) a.in[i] = (const float*)d_in[i];
    a.out = (float*)d_out; a.ws = (unsigned char*)d_ws;
    if (hipMemsetAsync((char*)d_ws + WS_BAR, 0, XCD_BAR_WORDS * 4, stream) != hipSuccess) { fprintf(stderr, "kernel_launch: memset of the barrier words failed\n"); return; }
    void* args[] = {&a};
    hipError_t e = hipLaunchCooperativeKernel((const void*)fwd_megakernel, dim3(grid), dim3(512), args, LDS_BYTES, stream);
    if (e != hipSuccess) fprintf(stderr, "cooperative launch failed: %s (grid %d)\n", hipGetErrorString(e), grid);
}
```

```cpp
#include <hip/hip_runtime.h>
#include <hip/hip_cooperative_groups.h>
#include <cstdio>
#include <cstdint>
namespace cg = cooperative_groups;

#define LAS __attribute__((address_space(3)))
typedef unsigned short bf16_t;
typedef short bf16x8 __attribute__((ext_vector_type(8)));
typedef short s16x4 __attribute__((ext_vector_type(4)));
typedef float f32x4 __attribute__((ext_vector_type(4)));
typedef float f32x16 __attribute__((ext_vector_type(16)));
typedef unsigned u32x4 __attribute__((ext_vector_type(4)));
typedef unsigned u32x2 __attribute__((ext_vector_type(2)));

constexpr int DM = 1024, NB = 32, SEQ = 2048, NTOK = NB * SEQ;
constexpr int NHEAD = 8, QKD = 192, NOPE = 128, ROPE = 64, VD = 128, QR = 384, KVR = 256;
constexpr int N0P = 1792;
constexpr float RMS_EPS = 1e-6f;

constexpr size_t MiB = 1u << 20;
constexpr size_t WS_W0   = 0;
constexpr size_t WS_WUQ  = 4 * MiB;
constexpr size_t WS_WUKV = 6 * MiB;
constexpr size_t WS_WO0  = 7 * MiB;
constexpr size_t WS_W1   = 9 * MiB;
constexpr size_t WS_WO1  = 17 * MiB;
constexpr size_t WS_ROPE = 19 * MiB;
constexpr size_t WS_GEN  = 20 * MiB;
constexpr size_t WS_BAR  = 38 * MiB;
constexpr size_t WS_R1   = 40 * MiB;
constexpr size_t WS_R2   = 168 * MiB;
constexpr size_t WS_SSQ  = 36 * MiB;
constexpr size_t WS_CQN  = 456 * MiB;
constexpr size_t WS_CKVN = 504 * MiB;
constexpr size_t WS_KPE  = 536 * MiB;
constexpr size_t WS_Q    = 544 * MiB;
constexpr size_t WS_KV   = 736 * MiB;
constexpr size_t WS_HB   = 864 * MiB;
constexpr size_t WS_UT   = 296 * MiB;
constexpr size_t WS_ZG   = 736 * MiB;
constexpr size_t WS_END  = 992 * MiB;

constexpr int LDS_BYTES = 147456;

__device__ __forceinline__ unsigned cvtpk(float lo, float hi) { unsigned r; asm volatile("v_cvt_pk_bf16_f32 %0, %1, %2" : "=v"(r) : "v"(lo), "v"(hi)); return r; }
__device__ __forceinline__ float bf2f(unsigned short h) { return __uint_as_float(((unsigned)h) << 16); }
__device__ __forceinline__ float bflo(unsigned w) { return __uint_as_float(w << 16); }
__device__ __forceinline__ float bfhi(unsigned w) { return __uint_as_float(w & 0xffff0000u); }
__device__ __forceinline__ unsigned short f2bf(float f) { return (unsigned short)(cvtpk(f, 0.f) & 0xffffu); }
__device__ __forceinline__ float wave_sum(float v) {
#pragma unroll
    for (int o = 1; o < 64; o <<= 1) v += __shfl_xor(v, o);
    return v;
}
__device__ __forceinline__ float silu_f(float x) { return x * __builtin_amdgcn_rcpf(1.f + __builtin_amdgcn_exp2f(-1.4426950408889634f * x)); }
__device__ __forceinline__ void sincos_cw(float x, float& s, float& c) {
    const float k = rintf(x * 0.63661977236758134f);
    float r = fmaf(-k, 1.5703125f, x); r = fmaf(-k, 4.837512969970703125e-4f, r); r = fmaf(-k, 7.54978995489188216e-8f, r);
    const float z = r * r;
    const float sp = fmaf(fmaf(fmaf(-1.9515295891e-4f, z, 8.3321608736e-3f), z, -1.6666654611e-1f) * z, r, r);
    const float cp = fmaf(fmaf(fmaf(2.443315711809948e-5f, z, -1.388731625493765e-3f), z, 4.166664568298827e-2f), z * z, fmaf(-0.5f, z, 1.f));
    const int q = ((int)k) & 3;
    const float ss = (q & 1) ? cp : sp, cc = (q & 1) ? sp : cp;
    s = (q & 2) ? -ss : ss; c = ((q + 1) & 2) ? -cc : cc;
}
__device__ __forceinline__ float sin_cw(float x) { float s, c; sincos_cw(x, s, c); return s; }
namespace pg8 {
#define PG8_LAS __attribute__((address_space(3)))
typedef unsigned short bf16_t;
typedef short bf16x8 __attribute__((ext_vector_type(8)));
typedef float f32x4 __attribute__((ext_vector_type(4)));
typedef unsigned u32x4 __attribute__((ext_vector_type(4)));
constexpr int BM = 256, BK = 64, HALF = 128, HTB = HALF * BK * 2  , STAGE_BYTES = 8 * HTB, NXCD = 8, WGM = 8;

__host__ __device__ __forceinline__ int lds_byte(int r, int c) { const int st = (r >> 4) * 2 + (c >> 5), rr = r & 15, cc = c & 31, ob = rr * 64 + cc * 2; return st * 1024 + (ob ^ (((ob >> 9) & 1) << 5)); }
__host__ __device__ __forceinline__ void stage_rc(int b, int& R, int& C) { const int st = b / 1024, sb = b % 1024, swz = sb ^ (((sb >> 9) & 1) << 5); R = (st >> 1) * 16 + swz / 64; C = (st & 1) * 32 + (swz % 64) / 2; }
__host__ __device__ __forceinline__ int perm32(int rho) { const int n = rho >> 4, i = rho & 15; return 8 * (i >> 2) + 4 * n + (i & 3); }

struct Unit { int pm, pn; };
struct Gemm { const bf16_t* A; const bf16_t* Bt; int M, N, K; };

struct StaticOrder {
    int nM, nN, nwg, G, c;
    __host__ __device__ void init(int M, int N, int G_, int c_) { nM = M / BM; nN = N / BM; nwg = nM * nN; G = G_; c = c_; }
    __host__ __device__ bool next(int i, Unit& u) const {
        const long L = (long)i * G + c; if (L >= nwg) return false;
        int wgid = (int)L; { const int q = nwg / NXCD, r = nwg % NXCD, xcd = wgid % NXCD, off = wgid / NXCD; wgid = (xcd < r ? xcd * (q + 1) : r * (q + 1) + (xcd - r) * q) + off; }
        const int nig = WGM * nN, gid = wgid / nig, fm = gid * WGM, gsz = (nM - fm) < WGM ? (nM - fm) : WGM;
        u.pm = fm + ((wgid % nig) % gsz); u.pn = (wgid % nig) / gsz; return true;
    }
    __device__ __forceinline__ void a_ready(const Unit&) const {}
    __device__ __forceinline__ void done(const Unit&) const {}
};

template <class Epi, class Sched, bool ALIGN_EPI = false, bool SP2 = false>
__device__ __forceinline__ void gemm_phase(PG8_LAS unsigned char* lds, const Gemm g, const Sched& S, const Epi& E) {
    int tid_o = threadIdx.x; asm volatile("" : "+v"(tid_o));
    const int tid = tid_o, wid = __builtin_amdgcn_readfirstlane(tid >> 6), lane = tid & 63, wr = wid >> 2, wc = wid & 3, fr = lane & 15, fq = lane >> 4;
    const int K = g.K, nt = K / BK;
    unsigned voffA[2], voffB[2];
#pragma unroll
    for (int i = 0; i < 2; ++i) { int R, C; stage_rc(tid * 16 + i * 8192, R, C); const int Rb = Epi::PERM ? ((R & ~31) + perm32(R & 31)) : R;
        voffA[i] = (unsigned)(R * K + C) * 2u; voffB[i] = (unsigned)(Rb * K + C) * 2u; }
    const size_t kstep = (size_t)(BK * 2);
    const size_t hstep = (size_t)HALF * K * 2;
    const size_t tstep = 2 * hstep;
    const unsigned ldsw = (unsigned)wid * 1024u;
    const int aoff = lds_byte(wr * 64 + fr, fq * 8), boff = lds_byte(wc * 32 + fr, fq * 8);
#define PG8_SA(b, h) (((b) * 2 + (h)) * HTB)
#define PG8_SB(b, h) ((4 + (b) * 2 + (h)) * HTB)
#define PG8_STAGE(bufoff, gbase, voff) do { _Pragma("unroll") for (int _i = 0; _i < 2; ++_i) \
        __builtin_amdgcn_global_load_lds((const unsigned*)((const char*)(gbase) + (voff)[_i]), (PG8_LAS unsigned*)(lds + (bufoff) + ldsw + _i * 8192), 16, 0, 0); } while (0)
#define PG8_LDA(dst, b, h) do { _Pragma("unroll") for (int m = 0; m < 4; ++m) _Pragma("unroll") for (int k = 0; k < 2; ++k) dst[m][k] = *(const PG8_LAS bf16x8*)(lds + PG8_SA(b, h) + aoff + m * 2048 + k * 1024); } while (0)
#define PG8_LDB(dst, b, h) do { _Pragma("unroll") for (int n = 0; n < 2; ++n) _Pragma("unroll") for (int k = 0; k < 2; ++k) dst[n][k] = *(const PG8_LAS bf16x8*)(lds + PG8_SB(b, h) + boff + n * 2048 + k * 1024); } while (0)
#define PG8_MMA(ai, bj, At, Bt) do { __builtin_amdgcn_s_setprio(1); _Pragma("unroll") for (int m = 0; m < 4; ++m) _Pragma("unroll") for (int n = 0; n < 2; ++n) _Pragma("unroll") for (int k = 0; k < 2; ++k) \
        acc[ai][bj][m][n] = __builtin_amdgcn_mfma_f32_16x16x32_bf16(Bt[n][k], At[m][k], acc[ai][bj][m][n], 0, 0, 0); __builtin_amdgcn_s_setprio(0); } while (0)
#define PG8_WAIT_V(n) asm volatile("s_waitcnt vmcnt(" #n ")" ::: "memory")
#define PG8_WAIT_L(n) asm volatile("s_waitcnt lgkmcnt(" #n ")" ::: "memory")
#define PG8_BAR __builtin_amdgcn_s_barrier()
#define PG8_SCHED __builtin_amdgcn_sched_barrier(0)
    Unit cur, nxt; int ui = 0;
    if (!S.next(0, cur)) return;
    f32x4 acc[2][2][4][2];
#pragma unroll
    for (int a = 0; a < 2; ++a)
#pragma unroll
        for (int b = 0; b < 2; ++b)
#pragma unroll
            for (int m = 0; m < 4; ++m)
#pragma unroll
                for (int n = 0; n < 2; ++n) acc[a][b][m][n] = (f32x4){0.f, 0.f, 0.f, 0.f};
    bf16x8 At[4][2], B0[2][2], B1[2][2];
    const char* cA = (const char*)g.A + (size_t)cur.pm * tstep; const char* cB = (const char*)g.Bt + (size_t)cur.pn * tstep;
    S.a_ready(cur);
    if constexpr (SP2) {
        PG8_STAGE(PG8_SB(0, 0), cB, voffB); PG8_STAGE(PG8_SB(0, 1), cB + hstep, voffB); PG8_STAGE(PG8_SA(0, 0), cA, voffA); PG8_STAGE(PG8_SA(0, 1), cA + hstep, voffA);
        if (wr == 1) PG8_BAR;
        PG8_WAIT_V(2); PG8_BAR;
        PG8_STAGE(PG8_SB(1, 0), cB + kstep, voffB); PG8_STAGE(PG8_SA(1, 0), cA + kstep, voffA); PG8_STAGE(PG8_SB(1, 1), cB + hstep + kstep, voffB);
        PG8_WAIT_V(6); PG8_BAR;
    } else {
        PG8_STAGE(PG8_SB(0, 0), cB, voffB); PG8_STAGE(PG8_SA(0, 0), cA, voffA); PG8_STAGE(PG8_SB(0, 1), cB + hstep, voffB); PG8_STAGE(PG8_SA(0, 1), cA + hstep, voffA);
        if (wr == 1) PG8_BAR;
        PG8_WAIT_V(4); PG8_BAR;
        PG8_STAGE(PG8_SB(1, 0), cB + kstep, voffB); PG8_STAGE(PG8_SA(1, 0), cA + kstep, voffA); PG8_STAGE(PG8_SB(1, 1), cB + hstep + kstep, voffB);
        PG8_WAIT_V(6); PG8_BAR;
    }
    for (;;) {
        const bool has_next = S.next(ui + 1, nxt);
        const char* nA = has_next ? (const char*)g.A + (size_t)nxt.pm * tstep : cA; const char* nB = has_next ? (const char*)g.Bt + (size_t)nxt.pn * tstep : cB;
        for (int t = 0; t < nt; t += 2) {
            const bool last = (t == nt - 2);
            const char* a1 = cA + (size_t)(t + 1) * kstep;
            const char* a2 = last ? nA : cA + (size_t)(t + 2) * kstep; const char* b2 = last ? nB : cB + (size_t)(t + 2) * kstep;
            const char* a3 = a2 + kstep; const char* b3 = b2 + kstep;
            if (last && has_next) S.a_ready(nxt);
            if constexpr (SP2) {
            PG8_LDB(B0, 0, 0); PG8_LDB(B1, 0, 1); PG8_SCHED; PG8_LDA(At, 0, 0); PG8_STAGE(PG8_SA(1, 1), a1 + hstep, voffA);
            PG8_WAIT_V(8); PG8_WAIT_L(0); PG8_BAR; PG8_MMA(0, 0, At, B0); PG8_MMA(0, 1, At, B1); PG8_BAR; PG8_SCHED;
            PG8_LDA(At, 0, 1); PG8_STAGE(PG8_SB(0, 0), b2, voffB); PG8_STAGE(PG8_SB(0, 1), b2 + hstep, voffB); PG8_STAGE(PG8_SA(0, 0), a2, voffA);
            PG8_WAIT_V(8); PG8_WAIT_L(0); PG8_BAR; PG8_MMA(1, 0, At, B0); PG8_MMA(1, 1, At, B1); PG8_BAR; PG8_SCHED;
            PG8_LDB(B0, 1, 0); PG8_LDB(B1, 1, 1); PG8_SCHED; PG8_LDA(At, 1, 0); PG8_STAGE(PG8_SA(0, 1), a2 + hstep, voffA);
            PG8_WAIT_V(8); PG8_WAIT_L(0); PG8_BAR; PG8_MMA(0, 0, At, B0); PG8_MMA(0, 1, At, B1); PG8_BAR; PG8_SCHED;
            PG8_LDA(At, 1, 1); PG8_STAGE(PG8_SB(1, 0), b3, voffB); PG8_STAGE(PG8_SB(1, 1), b3 + hstep, voffB); PG8_STAGE(PG8_SA(1, 0), a3, voffA);
            PG8_WAIT_V(8); PG8_WAIT_L(0); PG8_BAR; PG8_MMA(1, 0, At, B0); PG8_MMA(1, 1, At, B1); PG8_BAR; PG8_SCHED;
            } else {
            PG8_LDB(B0, 0, 0); PG8_SCHED; PG8_LDA(At, 0, 0); PG8_STAGE(PG8_SA(1, 1), a1 + hstep, voffA);
            PG8_WAIT_L(8); PG8_BAR; PG8_WAIT_L(0); PG8_MMA(0, 0, At, B0); PG8_BAR; PG8_SCHED;
            PG8_LDB(B1, 0, 1); PG8_STAGE(PG8_SB(0, 0), b2, voffB);
            PG8_BAR; PG8_WAIT_L(0); PG8_MMA(0, 1, At, B1); PG8_BAR;
            PG8_LDA(At, 0, 1); PG8_STAGE(PG8_SA(0, 0), a2, voffA);
            PG8_BAR; PG8_WAIT_L(0); PG8_MMA(1, 0, At, B0); PG8_BAR; PG8_SCHED;
            PG8_STAGE(PG8_SB(0, 1), b2 + hstep, voffB);
            PG8_WAIT_V(6); PG8_BAR; PG8_MMA(1, 1, At, B1); PG8_BAR;
            PG8_LDB(B0, 1, 0); PG8_SCHED; PG8_LDA(At, 1, 0); PG8_STAGE(PG8_SA(0, 1), a2 + hstep, voffA);
            PG8_WAIT_L(8); PG8_BAR; PG8_WAIT_L(0); PG8_MMA(0, 0, At, B0); PG8_BAR; PG8_SCHED;
            PG8_LDB(B1, 1, 1); PG8_STAGE(PG8_SB(1, 0), b3, voffB);
            PG8_BAR; PG8_WAIT_L(0); PG8_MMA(0, 1, At, B1); PG8_BAR;
            PG8_LDA(At, 1, 1); PG8_STAGE(PG8_SA(1, 0), a3, voffA);
            PG8_BAR; PG8_WAIT_L(0); PG8_MMA(1, 0, At, B0); PG8_BAR; PG8_SCHED;
            PG8_STAGE(PG8_SB(1, 1), b3 + hstep, voffB);
            PG8_WAIT_V(6); PG8_BAR; PG8_MMA(1, 1, At, B1); PG8_BAR;
            }
        }
        if constexpr (ALIGN_EPI) { if (wr == 0) PG8_BAR; }
        if constexpr (!Epi::AFTER_DRAIN) { E(acc, cur, wr, wc, fr, fq); S.done(cur); }
        if (!has_next) break;
#pragma unroll
        for (int a = 0; a < 2; ++a)
#pragma unroll
            for (int b = 0; b < 2; ++b)
#pragma unroll
                for (int m = 0; m < 4; ++m)
#pragma unroll
                    for (int n = 0; n < 2; ++n) acc[a][b][m][n] = (f32x4){0.f, 0.f, 0.f, 0.f};
        cur = nxt; cA = nA; cB = nB; ++ui;
        if constexpr (ALIGN_EPI) { if (wr == 1) PG8_BAR; }
    }
    PG8_WAIT_V(0);
    if constexpr (!ALIGN_EPI) { if (wr == 0) PG8_BAR; }
    PG8_BAR;
    if constexpr (Epi::AFTER_DRAIN) { E.fused(acc, cur, wr, wc, fr, fq, lds, wid, lane); S.done(cur); }
#undef PG8_SA
#undef PG8_SB
#undef PG8_STAGE
#undef PG8_LDA
#undef PG8_LDB
#undef PG8_MMA
#undef PG8_WAIT_V
#undef PG8_WAIT_L
#undef PG8_BAR
#undef PG8_SCHED
}
}

template <class F> struct EpiRows {
    static constexpr bool PERM = true, AFTER_DRAIN = false;
    F f;
    __device__ __forceinline__ void operator()(const pg8::f32x4 (&acc)[2][2][4][2], const pg8::Unit& u, int, int, int, int) const {
        int t_ = threadIdx.x; asm volatile("" : "+v"(t_));
        const int ln_ = t_ & 63, wd_ = t_ >> 6, wr = wd_ >> 2, wc = wd_ & 3, fr = ln_ & 15, fq = ln_ >> 4;
        const int row0 = u.pm * 256 + wr * 64 + fr, col0 = u.pn * 256 + wc * 32 + 8 * fq;
#pragma unroll
        for (int ai = 0; ai < 2; ++ai)
#pragma unroll
            for (int m = 0; m < 4; ++m)
#pragma unroll
                for (int bj = 0; bj < 2; ++bj) f(row0 + ai * 128 + m * 16, col0 + bj * 128, acc[ai][bj][m][0], acc[ai][bj][m][1]);
    }
};
__device__ __forceinline__ u32x4 pack8(f32x4 a, f32x4 b) { u32x4 w; w.x = cvtpk(a[0], a[1]); w.y = cvtpk(a[2], a[3]); w.z = cvtpk(b[0], b[1]); w.w = cvtpk(b[2], b[3]); return w; }
__device__ __forceinline__ f32x4 silu4(f32x4 v) { return (f32x4){silu_f(v[0]), silu_f(v[1]), silu_f(v[2]), silu_f(v[3])}; }
__device__ __forceinline__ void rope8(const float* rope, int pos, int q, f32x4& v0, f32x4& v1) {
    const f32x4 c = *(const f32x4*)(rope + pos * 32 + 4 * q), s = *(const f32x4*)(rope + SEQ * 32 + pos * 32 + 4 * q);
    const f32x4 a = v0 * c - v1 * s, b = v0 * s + v1 * c; v0 = a; v1 = b;
}
__device__ __forceinline__ float sq8(f32x4 a, f32x4 b) { return (a[0] * a[0] + a[1] * a[1]) + (a[2] * a[2] + a[3] * a[3]) + (b[0] * b[0] + b[1] * b[1]) + (b[2] * b[2] + b[3] * b[3]); }
__device__ __forceinline__ float row_sum4(float p) { p += __shfl_xor(p, 16); p += __shfl_xor(p, 32); return p; }
__device__ __forceinline__ bool fq_is0() { return (threadIdx.x & 48) == 0; }
struct F_G1 { bf16_t* cq; bf16_t* ckv; float* ssq_q; float* ssq_kv; bf16_t* kpe; bf16_t* sg; const float* rope;
    __device__ __forceinline__ void operator()(int row, int col, f32x4 v0, f32x4 v1) const {
        if (col < 640) { const float p = row_sum4(sq8(v0, v1));
            if (col < 384) { *(u32x4*)(cq + (size_t)row * 384 + col) = pack8(v0, v1); if (fq_is0()) unsafeAtomicAdd(ssq_q + row, p); }
            else { *(u32x4*)(ckv + (size_t)row * 256 + (col - 384)) = pack8(v0, v1); if (fq_is0()) unsafeAtomicAdd(ssq_kv + row, p); } }
        else if (col < 704) { rope8(rope, row & (SEQ - 1), (col - 640) >> 3, v0, v1); *(u32x4*)(kpe + (size_t)row * 64 + (col - 640)) = pack8(v0, v1); }
        else if (col >= 768) { *(u32x4*)(sg + (size_t)row * 1024 + (col - 768)) = pack8(silu4(v0), silu4(v1)); }
    } };
struct F_G2Q { bf16_t* q; const float* rope;
    __device__ __forceinline__ void operator()(int row, int col, f32x4 v0, f32x4 v1) const {
        const int j = col % 192;
        if (j >= 128) rope8(rope, row & (SEQ - 1), (j - 128) >> 3, v0, v1);
        *(u32x4*)(q + (size_t)row * 1536 + col) = pack8(v0, v1);
    } };
struct F_G2KV { bf16_t* o; const float* ssq;
    __device__ __forceinline__ void operator()(int row, int col, f32x4 v0, f32x4 v1) const {
        const float r = __builtin_amdgcn_rsqf(ssq[row] * (1.f / 256.f) + RMS_EPS); *(u32x4*)(o + (size_t)row * 2048 + col) = pack8(v0 * r, v1 * r); } };
struct F_BF16 { bf16_t* o; size_t ld;
    __device__ __forceinline__ void operator()(int row, int col, f32x4 v0, f32x4 v1) const { *(u32x4*)(o + (size_t)row * ld + col) = pack8(v0, v1); } };
struct F_SILU { bf16_t* o;
    __device__ __forceinline__ void operator()(int row, int col, f32x4 v0, f32x4 v1) const { *(u32x4*)(o + (size_t)row * 1024 + col) = pack8(silu4(v0), silu4(v1)); } };
struct F_RES { const float* base; float* out;
    __device__ __forceinline__ void operator()(int row, int col, f32x4 v0, f32x4 v1) const {
        const size_t i = (size_t)row * 1024 + col; const f32x4 b0 = *(const f32x4*)(base + i), b1 = *(const f32x4*)(base + i + 4);
        *(f32x4*)(out + i) = b0 + v0; *(f32x4*)(out + i + 4) = b1 + v1; } };
struct F_RES1 { const float* base; float* out; bf16_t* hb; float* ssq;
    __device__ __forceinline__ void operator()(int row, int col, f32x4 v0, f32x4 v1) const {
        const size_t i = (size_t)row * 1024 + col; const f32x4 h0 = *(const f32x4*)(base + i) + v0, h1 = *(const f32x4*)(base + i + 4) + v1;
        *(f32x4*)(out + i) = h0; *(f32x4*)(out + i + 4) = h1; *(u32x4*)(hb + i) = pack8(h0, h1);
        const float p = row_sum4(sq8(h0, h1)); if (fq_is0()) unsafeAtomicAdd(ssq + row, p); } };
struct F_UT { bf16_t* o; const float* ssq;
    __device__ __forceinline__ void operator()(int row, int col, f32x4 v0, f32x4 v1) const {
        const f32x4 s0 = *(const f32x4*)(ssq + col), s1 = *(const f32x4*)(ssq + col + 4); f32x4 r0, r1;
#pragma unroll
        for (int e = 0; e < 4; ++e) { r0[e] = __builtin_amdgcn_rsqf(s0[e] * (1.f / 1024.f) + RMS_EPS); r1[e] = __builtin_amdgcn_rsqf(s1[e] * (1.f / 1024.f) + RMS_EPS); }
        *(u32x4*)(o + (size_t)row * NTOK + col) = pack8(v0 * r0, v1 * r1); } };
struct F_SILU1 { bf16_t* o; const float* ssq;
    __device__ __forceinline__ void operator()(int row, int col, f32x4 v0, f32x4 v1) const {
        const float r = __builtin_amdgcn_rsqf(ssq[row] * (1.f / 1024.f) + RMS_EPS); *(u32x4*)(o + (size_t)row * 1024 + col) = pack8(silu4(v0 * r), silu4(v1 * r)); } };

namespace att {
constexpr int NW = 8, QBLK = 32, KVBLK = 64;
constexpr float SCALE = 0.07216878364870322f;
constexpr float THR = 8.f;
constexpr int BUF_KN = 0, BUF_KP = 16384, BUF_V = 24576, BUF_BYTES = 40960, LDS_WS = 3 * BUF_BYTES;
constexpr int SHM_ATTN = LDS_WS + NW * 64 * 4;
#define SBAR() __builtin_amdgcn_sched_barrier(0)
__device__ __forceinline__ int crow(int r, int hi) { return (r & 3) + 8 * (r >> 2) + 4 * hi; }

__device__ __forceinline__ void partialSM(f32x16& p0, f32x16& p1, float& m_reg, float& mn, float& alpha, float rq) {
  constexpr float C = SCALE * 1.4426950408889634f;
  float pmax = p0[0];
#pragma unroll
  for (int r = 1; r < 16; ++r) pmax = fmaxf(pmax, p0[r]);
#pragma unroll
  for (int r = 0; r < 16; ++r) pmax = fmaxf(pmax, p1[r]);
  { auto rr = __builtin_amdgcn_permlane32_swap(__float_as_uint(pmax), __float_as_uint(pmax), false, false);
    pmax = fmaxf(__uint_as_float(rr[0]), __uint_as_float(rr[1])) * rq; }
  if (__builtin_expect(__all(pmax - m_reg <= THR / SCALE), 1)) { mn = m_reg; alpha = 1.f; }
  else { mn = fmaxf(m_reg, pmax); alpha = __builtin_amdgcn_exp2f((m_reg - mn) * C); m_reg = mn; }
  const float mnC = -mn * C, Cq = C * rq;
#pragma unroll
  for (int r = 0; r < 16; ++r) p0[r] = fmaf(p0[r], Cq, mnC);
#pragma unroll
  for (int r = 0; r < 16; ++r) p1[r] = fmaf(p1[r], Cq, mnC);
#pragma unroll
  for (int r = 0; r < 16; ++r) p0[r] = __builtin_amdgcn_exp2f(p0[r]);
}
__device__ __forceinline__ void finishSM(f32x16& p0, f32x16& p1, float alpha, float& l_reg, bf16x8& pa0, bf16x8& pa1, bf16x8& pa2, bf16x8& pa3) {
#pragma unroll
  for (int r = 0; r < 16; ++r) p1[r] = __builtin_amdgcn_exp2f(p1[r]);
  float ps = 0;
#pragma unroll
  for (int r = 0; r < 16; ++r) ps += p0[r];
#pragma unroll
  for (int r = 0; r < 16; ++r) ps += p1[r];
  { auto rr = __builtin_amdgcn_permlane32_swap(__float_as_uint(ps), __float_as_uint(ps), false, false);
    ps = __uint_as_float(rr[0]) + __uint_as_float(rr[1]); }
  l_reg = l_reg * alpha + ps;
#define PK4(P, BASE, OUT) do { unsigned a0 = cvtpk(P[BASE + 0], P[BASE + 1]), a1 = cvtpk(P[BASE + 2], P[BASE + 3]);   \
    unsigned b0 = cvtpk(P[BASE + 4], P[BASE + 5]), b1 = cvtpk(P[BASE + 6], P[BASE + 7]);                              \
    auto r0 = __builtin_amdgcn_permlane32_swap(a0, b0, false, false); auto r1 = __builtin_amdgcn_permlane32_swap(a1, b1, false, false); \
    u32x4 w = {r0[0], r1[0], r0[1], r1[1]}; OUT = *reinterpret_cast<bf16x8*>(&w); } while (0)
  PK4(p0, 0, pa0); PK4(p0, 8, pa1); PK4(p1, 0, pa2); PK4(p1, 8, pa3);
#undef PK4
}
__device__ __forceinline__ void qkt(f32x16& p0, f32x16& p1, const char* Kb, const bf16x8* qr, int an, int tn, int ap, int tp) {
  p0 = f32x16{}; p1 = f32x16{};
#pragma unroll
  for (int d0 = 0; d0 < 8; ++d0) { const int o = an + (((2 * d0) ^ tn) << 4);
    bf16x8 b0 = *reinterpret_cast<const bf16x8*>(Kb + o);
    bf16x8 b1 = *reinterpret_cast<const bf16x8*>(Kb + o + 32 * 256);
    p0 = __builtin_amdgcn_mfma_f32_32x32x16_bf16(b0, qr[d0], p0, 0, 0, 0);
    p1 = __builtin_amdgcn_mfma_f32_32x32x16_bf16(b1, qr[d0], p1, 0, 0, 0); }
#pragma unroll
  for (int d0 = 0; d0 < 4; ++d0) { const int o = ap + (((2 * d0) ^ tp) << 4);
    bf16x8 b0 = *reinterpret_cast<const bf16x8*>(Kb + o);
    bf16x8 b1 = *reinterpret_cast<const bf16x8*>(Kb + o + 32 * 128);
    p0 = __builtin_amdgcn_mfma_f32_32x32x16_bf16(b0, qr[8 + d0], p0, 0, 0, 0);
    p1 = __builtin_amdgcn_mfma_f32_32x32x16_bf16(b1, qr[8 + d0], p1, 0, 0, 0); }
}
__device__ __forceinline__ int v_st(int k, int c) { const int kk = (k & ~0xC) | ((k & 4) << 1) | ((k & 8) >> 1); return ((kk >> 3) * 4 + (c >> 5)) * 512 + ((kk & 7) * 32 + (c & 31)) * 2; }
__device__ __forceinline__ int v_rd_base(int lane) { return ((lane & 3) << 3) | (((lane >> 2) & 3) << 6) | (((lane >> 4) & 1) << 5) | (((lane >> 5) & 1) << 8); }
constexpr int v_rd_off(int d0, int ks, int half) { return d0 * 512 + ks * 4096 + half * 2048; }
template <int OFF> __device__ __forceinline__ s16x4 tr_read(int vb) {
  s16x4 r; asm volatile("ds_read_b64_tr_b16 %0, %1 offset:%2" : "=&v"(r) : "v"(vb), "i"(OFF) : "memory"); return r;
}
template <int D0> __device__ __forceinline__ void pv_one(f32x16& od, int vb, bf16x8 pa0, bf16x8 pa1, bf16x8 pa2, bf16x8 pa3) {
  const s16x4 l0 = tr_read<v_rd_off(D0, 0, 0)>(vb), h0 = tr_read<v_rd_off(D0, 0, 1)>(vb), l1 = tr_read<v_rd_off(D0, 1, 0)>(vb), h1 = tr_read<v_rd_off(D0, 1, 1)>(vb);
  const s16x4 l2 = tr_read<v_rd_off(D0, 2, 0)>(vb), h2 = tr_read<v_rd_off(D0, 2, 1)>(vb), l3 = tr_read<v_rd_off(D0, 3, 0)>(vb), h3 = tr_read<v_rd_off(D0, 3, 1)>(vb);
  asm volatile("s_waitcnt lgkmcnt(0)" ::: "memory"); SBAR();
#define PK(L, H) (bf16x8){L[0], L[1], L[2], L[3], H[0], H[1], H[2], H[3]}
  od = __builtin_amdgcn_mfma_f32_32x32x16_bf16(pa0, PK(l0, h0), od, 0, 0, 0);
  od = __builtin_amdgcn_mfma_f32_32x32x16_bf16(pa1, PK(l1, h1), od, 0, 0, 0);
  od = __builtin_amdgcn_mfma_f32_32x32x16_bf16(pa2, PK(l2, h2), od, 0, 0, 0);
  od = __builtin_amdgcn_mfma_f32_32x32x16_bf16(pa3, PK(l3, h3), od, 0, 0, 0);
#undef PK
}
__device__ __forceinline__ void pv_d0(f32x16* o, int vb, bf16x8 pa0, bf16x8 pa1, bf16x8 pa2, bf16x8 pa3) {
  pv_one<0>(o[0], vb, pa0, pa1, pa2, pa3); pv_one<1>(o[1], vb, pa0, pa1, pa2, pa3); pv_one<2>(o[2], vb, pa0, pa1, pa2, pa3); pv_one<3>(o[3], vb, pa0, pa1, pa2, pa3);
}

__device__ __forceinline__ int v_src(int p, int l) { const int sub = 2 * p + (l >> 5), wq = l & 31, kk = (sub >> 2) * 8 + (wq >> 2), c = (sub & 3) * 32 + (wq & 3) * 8, k = (kk & ~0xC) | ((kk & 4) << 1) | ((kk & 8) >> 1); return k * 2048 + 128 + c; }
__device__ __forceinline__ void attn_unit(const bf16_t* __restrict__ Qb, const bf16_t* __restrict__ KVh, const bf16_t* __restrict__ KPb,
                                          const bf16_t* __restrict__ SGb, bf16_t* __restrict__ OGb, const float* __restrict__ ssqq, char* lds, LAS unsigned char* ldsl) {
  constexpr int LDQ = 1536, LDK = 2048, seq = SEQ;
  int tid_o = threadIdx.x; asm volatile("" : "+v"(tid_o));
  const int tid = tid_o, wid = __builtin_amdgcn_readfirstlane(tid >> 6), lane = tid & 63, r32 = lane & 31, hi = lane >> 5;
  float* ws = (float*)(lds + LDS_WS) + wid * 64; float* li_l = ws; float* al_l = ws + 32;
  float m_reg = -1e30f, l_reg = 0; f32x16 o[4] = {}; bf16x8 qr[12];
  const float rq = __builtin_amdgcn_rsqf(ssqq[wid * QBLK + r32] * (1.f / 384.f) + RMS_EPS);
  const bf16_t* Qw = Qb + (long)(wid * QBLK + r32) * LDQ + hi * 8;
#pragma unroll
  for (int d0 = 0; d0 < 12; ++d0) qr[d0] = *reinterpret_cast<const bf16x8*>(Qw + d0 * 16);
  int on0, on1, opp, ov0, ov1;
  { const int r0 = 8 * wid + (lane >> 4), r1 = r0 + 4, c16 = lane & 15;
    on0 = r0 * LDK + ((c16 ^ (r0 & 7)) << 3); on1 = r1 * LDK + ((c16 ^ (r1 & 7)) << 3);
    const int rp = 8 * wid + (lane >> 3), c8 = lane & 7; opp = rp * 64 + ((c8 ^ ((rp >> 1) & 7)) << 3);
    ov0 = v_src(2 * wid, lane); ov1 = v_src(2 * wid + 1, lane);
  }
  const int an = r32 * 256, tn = hi ^ (r32 & 7), ap = BUF_KP + r32 * 128, tp = hi ^ ((r32 >> 1) & 7);
  const int vrd = BUF_V + v_rd_base(lane);
  const int ldsb = (int)(uintptr_t)lds;
#define DMA1(gp_, off_) __builtin_amdgcn_global_load_lds((const unsigned*)(gp_), (LAS unsigned*)(ldsl + (off_)), 16, 0, 0)
#define DMA_TILE(k0, bo) do { const bf16_t* kb_ = KVh + (size_t)(k0) * LDK; const bf16_t* pb_ = KPb + (size_t)(k0) * 64; const int bw_ = (bo); \
    DMA1(kb_ + on0, bw_ + BUF_KN + wid * 2048); DMA1(kb_ + on1, bw_ + BUF_KN + wid * 2048 + 1024); DMA1(pb_ + opp, bw_ + BUF_KP + wid * 1024); \
    DMA1(kb_ + ov0, bw_ + BUF_V + wid * 2048); DMA1(kb_ + ov1, bw_ + BUF_V + wid * 2048 + 1024); } while (0)
#define WAITBAR(N) do { asm volatile("s_waitcnt vmcnt(" #N ")\n\ts_barrier" ::: "memory"); SBAR(); } while (0)
#define RESC(a) do { if (__any((a) < 1.f)) { if (hi == 0) al_l[r32] = (a); asm volatile("s_waitcnt lgkmcnt(0)" ::: "memory"); \
    _Pragma("unroll") for (int d = 0; d < 4; ++d) _Pragma("unroll") for (int r = 0; r < 16; ++r) o[d][r] *= al_l[crow(r, hi)]; } } while (0)
  f32x16 pA0, pA1, pB0, pB1; float mnA, mnB, alA, alB; bf16x8 pa0, pa1, pa2, pa3; constexpr int NT = seq / KVBLK;
  int bprv = 0, bcur = BUF_BYTES, bnxt = 2 * BUF_BYTES;
  DMA_TILE(0, 0); DMA_TILE(KVBLK, BUF_BYTES);
  WAITBAR(5);
  qkt(pA0, pA1, lds, qr, an, tn, ap, tp); partialSM(pA0, pA1, m_reg, mnA, alA, rq);
  WAITBAR(0);
  DMA_TILE(2 * KVBLK, 2 * BUF_BYTES);
#define STEP(P0_, P1_, mnP, alP, Q0_, Q1_, alQ, t_) do { \
    SBAR(); qkt(P0_, P1_, lds + bcur, qr, an, tn, ap, tp); \
    finishSM(Q0_, Q1_, alQ, l_reg, pa0, pa1, pa2, pa3); SBAR(); \
    pv_d0(o, ldsb + bprv + vrd, pa0, pa1, pa2, pa3); partialSM(P0_, P1_, m_reg, mnP, alP, rq); \
    RESC(alP); \
    WAITBAR(0);                                                      \
    if ((t_) + 2 < NT) DMA_TILE(((t_) + 2) * KVBLK, bprv); \
    { const int x_ = bprv; bprv = bcur; bcur = bnxt; bnxt = x_; } } while (0)
  for (int j = 1; j + 1 < NT; j += 2) {
    STEP(pB0, pB1, mnB, alB, pA0, pA1, alA, j);
    STEP(pA0, pA1, mnA, alA, pB0, pB1, alB, j + 1);
  }
  SBAR(); qkt(pB0, pB1, lds + bcur, qr, an, tn, ap, tp);
  finishSM(pA0, pA1, alA, l_reg, pa0, pa1, pa2, pa3); SBAR();
  pv_d0(o, ldsb + bprv + vrd, pa0, pa1, pa2, pa3); partialSM(pB0, pB1, m_reg, mnB, alB, rq);
  RESC(alB);
  finishSM(pB0, pB1, alB, l_reg, pa0, pa1, pa2, pa3); SBAR();
  pv_d0(o, ldsb + bcur + vrd, pa0, pa1, pa2, pa3);
  if (hi == 0) li_l[r32] = l_reg; asm volatile("s_waitcnt lgkmcnt(0)" ::: "memory");
  __syncthreads();
  int tid2 = tid; asm volatile("" : "+v"(tid2));
  const int wid2 = tid2 >> 6, lane2 = tid2 & 63;
  char* ost = lds + wid2 * 8704;
#pragma unroll
  for (int r = 0; r < 16; ++r) { const int orow = crow(r, hi); const float rl = __builtin_amdgcn_rcpf(li_l[orow]);
#pragma unroll
    for (int d0 = 0; d0 < 4; ++d0) *(bf16_t*)(ost + orow * 272 + (d0 * 32 + r32) * 2) = f2bf(o[d0][r] * rl); }
  asm volatile("s_waitcnt lgkmcnt(0)" ::: "memory");
  const int wrow = wid2 * QBLK;
#pragma unroll 2
  for (int k = 0; k < 8; ++k) { const int p = lane2 + 64 * k, row = p >> 4, pc = p & 15; const int idx = (wrow + row) * 1024 + pc * 8;
    const u32x4 ov = *(const u32x4*)(ost + row * 272 + pc * 16); const u32x4 sg = *(const u32x4*)(SGb + idx);
    u32x4 w; w.x = cvtpk(bflo(ov.x) * bflo(sg.x), bfhi(ov.x) * bfhi(sg.x)); w.y = cvtpk(bflo(ov.y) * bflo(sg.y), bfhi(ov.y) * bfhi(sg.y));
    w.z = cvtpk(bflo(ov.z) * bflo(sg.z), bfhi(ov.z) * bfhi(sg.z)); w.w = cvtpk(bflo(ov.w) * bflo(sg.w), bfhi(ov.w) * bfhi(sg.w));
    *(u32x4*)(OGb + idx) = w; }
  __syncthreads();
#undef DMA1
#undef DMA_TILE
#undef WAITBAR
#undef STEP
#undef RESC
}
}

namespace hy {
constexpr int GENW_BYTES = 4608;
constexpr int BPITCH = 528;
constexpr int BS_BYTES = 32 * BPITCH;
constexpr int LDS_GEN = 0, LDS_BS = 8 * GENW_BYTES;
constexpr int LDS_TOTAL = LDS_BS + 2 * BS_BYTES;
constexpr int EPITCH_W = 32 * 536;
__device__ __forceinline__ int crow(int r, int hi) { return (r & 3) + 8 * (r >> 2) + 4 * hi; }

template <bool SC>
__device__ __forceinline__ void conv_channel(const bf16_t* __restrict__ gen, const bf16_t* src, float w0, float w1, float w2, float cb,
                                             const bf16_t* __restrict__ mul, float mw0, float mw1, float mw2, float mb, bf16_t* dst, char* lds, bool do_epi = true) {
  int tid = threadIdx.x; asm volatile("" : "+v"(tid));
  const int wid = __builtin_amdgcn_readfirstlane(tid >> 6), lane = tid & 63, i16 = lane & 15, g4 = lane >> 4;
  char* genl = lds + LDS_GEN + wid * GENW_BYTES;
  { const bf16_t* gs = gen + (1792 - 256 * wid);
#pragma unroll
    for (int k = 0; k < 5; ++k) { const int pi = lane + 64 * k; if (pi < 288) *(u32x4*)(genl + pi * 16) = *(const u32x4*)(gs + pi * 8); } }
  const int sn = tid >> 4, sp = tid & 15;
  const int soff = sn * SEQ + sp * 8;
  u32x4 st_v[2]; unsigned short st_prev[2] = {0, 0}, st_next[2] = {0, 0};
#define CLOAD(ch) do { _Pragma("unroll") for (int h_ = 0; h_ < 2; ++h_) { const int s0_ = (ch) * 256 + h_ * 128 + sp * 8; st_v[h_] = *(const u32x4*)(src + soff + (ch) * 256 + h_ * 128); \
    if (SC) { st_prev[h_] = (s0_ > 0) ? src[soff + (ch) * 256 + h_ * 128 - 1] : (unsigned short)0; st_next[h_] = (s0_ + 8 < SEQ) ? src[soff + (ch) * 256 + h_ * 128 + 8] : (unsigned short)0; } } } while (0)
#define CWRITE(buf) do { _Pragma("unroll") for (int h_ = 0; h_ < 2; ++h_) { u32x4 w_ = st_v[h_]; if (SC) { float p_[10]; p_[0] = bf2f(st_prev[h_]); p_[9] = bf2f(st_next[h_]); \
      p_[1] = bflo(w_.x); p_[2] = bfhi(w_.x); p_[3] = bflo(w_.y); p_[4] = bfhi(w_.y); p_[5] = bflo(w_.z); p_[6] = bfhi(w_.z); p_[7] = bflo(w_.w); p_[8] = bfhi(w_.w); \
      float o_[8]; _Pragma("unroll") for (int k_ = 0; k_ < 8; ++k_) o_[k_] = fmaf(w0, p_[k_], fmaf(w1, p_[k_ + 1], fmaf(w2, p_[k_ + 2], cb))); \
      w_.x = cvtpk(o_[0], o_[1]); w_.y = cvtpk(o_[2], o_[3]); w_.z = cvtpk(o_[4], o_[5]); w_.w = cvtpk(o_[6], o_[7]); } \
    *(u32x4*)(lds + LDS_BS + (buf) * BS_BYTES + sn * BPITCH + h_ * 256 + sp * 16) = w_; } } while (0)
#ifndef CONV_REP_MAIN
#define CONV_REP_MAIN 1
#endif
  f32x4 acc[16][2];
  for (int rep_ = 0; rep_ < CONV_REP_MAIN; ++rep_) {
  CLOAD(0); CWRITE(0);
  const int e_l = 255 + 8 * g4 - i16;
  const char* abase = genl + ((e_l & ~1) * 2);
  const unsigned ash = (unsigned)(e_l & 1) * 16u;
#define AFRAG(dst_, dprime) do { const unsigned* ap_ = (const unsigned*)(abase + (dprime) * 2); \
    const unsigned d0_ = ap_[0], d1_ = ap_[1], d2_ = ap_[2], d3_ = ap_[3], d4_ = ap_[4]; \
    u32x4 f_; f_.x = __builtin_amdgcn_alignbit(d1_, d0_, ash); f_.y = __builtin_amdgcn_alignbit(d2_, d1_, ash); f_.z = __builtin_amdgcn_alignbit(d3_, d2_, ash); f_.w = __builtin_amdgcn_alignbit(d4_, d3_, ash); \
    dst_ = __builtin_bit_cast(bf16x8, f_); } while (0)
#pragma unroll
  for (int m = 0; m < 16; ++m) { acc[m][0] = (f32x4){0.f, 0.f, 0.f, 0.f}; acc[m][1] = (f32x4){0.f, 0.f, 0.f, 0.f}; }
  bf16x8 ring[16];
  __syncthreads();
#pragma unroll
  for (int q = 1; q < 15; ++q) AFRAG(ring[q], 16 * (q - 16));
  const char* bbase = lds + LDS_BS + i16 * BPITCH + g4 * 16;
  for (int it8 = 0; it8 < 8; ++it8) {
    if (it8 + 1 < 8) CLOAD(it8 + 1);
    __builtin_amdgcn_sched_barrier(0);
    const char* bb = bbase + (it8 & 1) * BS_BYTES;
#pragma unroll
    for (int ii = 0; ii < 8; ++ii) {
      const int dp = 32 * (it8 * 8 + ii);
      AFRAG(ring[(2 * ii + 15) & 15], dp - 16); AFRAG(ring[(2 * ii) & 15], dp);
      const bf16x8 b0 = *(const bf16x8*)(bb + ii * 64), b1 = *(const bf16x8*)(bb + ii * 64 + 16 * BPITCH);
#pragma unroll
      for (int m = 0; m < 16; ++m) {
        acc[m][0] = __builtin_amdgcn_mfma_f32_16x16x32_bf16(ring[(2 * ii - m) & 15], b0, acc[m][0], 0, 0, 0);
        acc[m][1] = __builtin_amdgcn_mfma_f32_16x16x32_bf16(ring[(2 * ii - m) & 15], b1, acc[m][1], 0, 0, 0);
      }
      __builtin_amdgcn_sched_barrier(0);
    }
    if (it8 + 1 < 8) CWRITE((it8 + 1) & 1);
    __syncthreads();
  }
  }
  if (!do_epi) return;
  int tid2 = tid; asm volatile("" : "+v"(tid2));
  const int wid2 = __builtin_amdgcn_readfirstlane(tid2 >> 6), lane2 = tid2 & 63, n2 = lane2 & 31, g2 = lane2 >> 5, i2 = lane2 & 15, q2 = lane2 >> 4;
  char* et = lds + wid2 * EPITCH_W;
  const int tw0 = 256 * wid2;
  { u32x4 rv[16];
#pragma unroll
    for (int k = 0; k < 16; ++k) { const int pi = lane2 + 64 * k, rn = pi >> 5, pp = pi & 31; rv[k] = *(const u32x4*)(mul + rn * SEQ + tw0 + pp * 8); }
    unsigned short hv = 0;
    if (g2 == 0) { if (tw0 > 0) hv = mul[n2 * SEQ + tw0 - 1]; } else { if (tw0 + 256 < SEQ) hv = mul[n2 * SEQ + tw0 + 256]; }
#pragma unroll
    for (int k = 0; k < 16; ++k) { const int pi = lane2 + 64 * k, rn = pi >> 5, pp = pi & 31; u32x2* d = (u32x2*)(et + rn * 536 + 8 + pp * 16); d[0] = (u32x2){rv[k].x, rv[k].y}; d[1] = (u32x2){rv[k].z, rv[k].w}; }
    *(unsigned short*)(et + n2 * 536 + (g2 ? 520 : 6)) = hv; }
  asm volatile("s_waitcnt lgkmcnt(0)" ::: "memory");
#pragma unroll
  for (int m = 0; m < 16; ++m)
#pragma unroll
    for (int nt = 0; nt < 2; ++nt) {
      const int tl = 16 * m + 4 * q2;
      char* ep = et + (i2 + 16 * nt) * 536 + 8 + tl * 2;
      const u32x2 pv = *(const u32x2*)ep;
      const float pm1 = bf2f(*(const unsigned short*)(ep - 2)), pp4 = bf2f(*(const unsigned short*)(ep + 8));
      const float p0 = bflo(pv.x), p1 = bfhi(pv.x), p2 = bflo(pv.y), p3 = bfhi(pv.y);
      const float x0 = fmaf(mw0, pm1, fmaf(mw1, p0, fmaf(mw2, p1, mb))), x1 = fmaf(mw0, p0, fmaf(mw1, p1, fmaf(mw2, p2, mb)));
      const float x2 = fmaf(mw0, p1, fmaf(mw1, p2, fmaf(mw2, p3, mb))), x3 = fmaf(mw0, p2, fmaf(mw1, p3, fmaf(mw2, pp4, mb)));
#ifdef PROBE_ROUND_Y
      _Pragma("unroll") for (int e_ = 0; e_ < 4; ++e_) acc[m][nt][e_] = bf2f(f2bf(acc[m][nt][e_]));
#endif
      acc[m][nt][0] *= x0; acc[m][nt][1] *= x1; acc[m][nt][2] *= x2; acc[m][nt][3] *= x3;
    }
  asm volatile("s_waitcnt lgkmcnt(0)" ::: "memory");
#pragma unroll
  for (int m = 0; m < 16; ++m)
#pragma unroll
    for (int nt = 0; nt < 2; ++nt) {
      const int tl = 16 * m + 4 * q2;
      u32x2 ov; ov.x = cvtpk(acc[m][nt][0], acc[m][nt][1]); ov.y = cvtpk(acc[m][nt][2], acc[m][nt][3]);
      *(u32x2*)(et + (i2 + 16 * nt) * 536 + 8 + tl * 2) = ov;
    }
  asm volatile("s_waitcnt lgkmcnt(0)" ::: "memory");
#pragma unroll
  for (int k = 0; k < 16; ++k) { const int pi = lane2 + 64 * k, rn = pi >> 5, pp = pi & 31; const u32x2* d = (const u32x2*)(et + rn * 536 + 8 + pp * 16);
    const u32x2 a0 = d[0], a1 = d[1]; *(u32x4*)(dst + rn * SEQ + tw0 + pp * 8) = (u32x4){a0.x, a0.y, a1.x, a1.y}; }
  __syncthreads();
#undef CLOAD
#undef CWRITE
#undef AFRAG
}
}

#define XB_TMO      128
#define XB_XCNT(j)  (256  + 64 * (j))
#define XB_XSUB(j)  (1280 + 64 * (j))
#define XB_XGEN(j)  (2304 + 64 * (j))
#define XB_TOP      3328
#define XB_TOPGEN   3392
#define XCD_BAR_WORDS 3456
#define XB_SPIN_CAP (1u << 18)

__device__ __forceinline__ unsigned xb_ld(unsigned* p)              { return __hip_atomic_load(p, __ATOMIC_RELAXED, __HIP_MEMORY_SCOPE_AGENT); }
__device__ __forceinline__ unsigned xb_add(unsigned* p, unsigned v) { return __hip_atomic_fetch_add(p, v, __ATOMIC_RELAXED, __HIP_MEMORY_SCOPE_AGENT); }
__device__ __forceinline__ unsigned xb_xcc_id() { return (unsigned)__builtin_amdgcn_s_getreg((3 << 11) | 20) & 0xFu; }
#define XB_SPIN(cond, bar) do { unsigned _sp = 0; while (cond) { __builtin_amdgcn_s_sleep(1); \
    if ((++_sp & 255u) == 0u) { if (xb_ld(&(bar)[XB_TMO])) break; if (_sp > XB_SPIN_CAP) { atomicAdd(&(bar)[XB_TMO], 1u); break; } } } } while (0)

struct XcdBarrier {
    unsigned* bar; unsigned x;
    volatile LAS unsigned* st;
};

__device__ __forceinline__ XcdBarrier xcd_barrier_post(unsigned* bar, volatile LAS unsigned* st) {
    XcdBarrier b; b.bar = bar; b.x = xb_xcc_id(); b.st = st;
    if (threadIdx.x == 0) (void)xb_add(&bar[XB_XCNT(b.x)], 1u);
    return b;
}
__device__ __forceinline__ void xcd_barrier_complete(unsigned* bar, unsigned x, unsigned& nloc, unsigned& nx) {
    const unsigned G = gridDim.x * gridDim.y * gridDim.z;
    unsigned sum, cnt, mine, sp = 0u;
    for (;;) {
        sum = 0u; cnt = 0u; mine = 0u;
#pragma unroll
        for (unsigned j = 0; j < 16; ++j) { const unsigned c = xb_ld(&bar[XB_XCNT(j)]); sum += c; cnt += (c > 0u) ? 1u : 0u; mine = (j == x) ? c : mine; }
        if (sum == G) break;
        __builtin_amdgcn_s_sleep(1);
        if ((++sp & 255u) == 0u) { if (xb_ld(&bar[XB_TMO])) break; if (sp > XB_SPIN_CAP) { atomicAdd(&bar[XB_TMO], 1u); break; } }
    }
    nloc = mine > 0u ? mine : 1u; nx = cnt > 0u ? cnt : 1u;
}

__device__ __forceinline__ void xcd_barrier(const XcdBarrier& b) {
    asm volatile("s_waitcnt vmcnt(0)" ::: "memory");
    __syncthreads();
    if (threadIdx.x == 0) {
        unsigned* bar = b.bar;
        __builtin_amdgcn_s_waitcnt(0);
        unsigned nloc = b.st[0], nx = b.st[1];
        if (nloc == 0u) { xcd_barrier_complete(bar, b.x, nloc, nx); b.st[0] = nloc; b.st[1] = nx; }
        const unsigned old = xb_add(&bar[XB_XSUB(b.x)], 1u);
        const unsigned gen = old / nloc;
        if (old + 1u == (gen + 1u) * nloc) {
            __builtin_amdgcn_fence(__ATOMIC_RELEASE, "agent");
            asm volatile("s_waitcnt vmcnt(0)" ::: "memory");
            const unsigned og = xb_add(&bar[XB_TOP], 1u);
            const unsigned tg = og / nx;
            if (og + 1u == (tg + 1u) * nx) xb_add(&bar[XB_TOPGEN], 1u);
            else XB_SPIN(xb_ld(&bar[XB_TOPGEN]) == tg, bar);
            __builtin_amdgcn_fence(__ATOMIC_ACQUIRE, "agent");
            xb_add(&bar[XB_XGEN(b.x)], 1u);
            asm volatile("s_waitcnt vmcnt(0)" ::: "memory");
        } else {
            XB_SPIN(xb_ld(&bar[XB_XGEN(b.x)]) == gen, bar);
            __builtin_amdgcn_fence(__ATOMIC_ACQUIRE, "agent");
            asm volatile("s_waitcnt vmcnt(0)" ::: "memory");
        }
    }
    __syncthreads();
}

#ifndef PH_MASK
#define PH_MASK 0xFFFF
#endif
#define PH(n) (((PH_MASK) >> (n)) & 1)
#ifndef REP_MASK
#define REP_MASK 0
#endif
#define NREP(n) (1 + (((REP_MASK) >> (n)) & 1))
struct Args { const float* in[23]; float* out; unsigned char* ws; };

enum { I_X = 0, I_L0N, I_L0WIN, I_L0QN, I_L0WUQ, I_L0KVN, I_L0WUKV, I_L0WOUT, I_L1N, I_L1WIN, I_L1CW, I_L1CB, I_FW1, I_FB1, I_FW2, I_FB2, I_FW3, I_FB3, I_FW4, I_FFREQ, I_FBIAS, I_L1WOUT, I_FN };

__device__ __forceinline__ int wmap(int which, int n) {
    if (which == 0) {
        if (n < 640) return n;
        if (n < 704) { const int s = n - 640, q = s >> 3, e = s & 7; return 640 + ((e < 4) ? (4 * q + e) : (32 + 4 * q + (e - 4))); }
        if (n < 768) return -1;
        return n - 64;
    }
    if (which == 1) {
        const int h = n / 192, j = n % 192;
        if (j < 128) return n;
        const int s = j - 128, q = s >> 3, e = s & 7; return h * 192 + 128 + ((e < 4) ? (4 * q + e) : (32 + 4 * q + (e - 4)));
    }
    return n;
}
__device__ __forceinline__ void transpose_item(const float* __restrict__ W, int K, int Nsrc, int Ndst, bf16_t* __restrict__ WT, int which, float* scr, int item, int lane, const float* __restrict__ kgain = nullptr) {
    const int nblk = Ndst / 32, kb = item / nblk, nb = item % nblk, k0 = 64 * kb, n0 = 32 * nb;
    const int sc = wmap(which, n0 + (lane & 31));
#pragma unroll 8
    for (int i = 0; i < 32; ++i) { const int kk = 2 * i + (lane >> 5); const float gk = kgain ? kgain[k0 + kk] : 1.f; scr[kk * 33 + (lane & 31)] = (sc >= 0) ? W[(size_t)(k0 + kk) * Nsrc + sc] * gk : 0.f; }
    asm volatile("s_waitcnt lgkmcnt(0)" ::: "memory");
    const int c = lane & 7;
#pragma unroll
    for (int j = 0; j < 4; ++j) { const int n = (lane >> 3) + 8 * j; const float* s = scr + (8 * c) * 33 + n;
        u32x4 o; o.x = cvtpk(s[0 * 33], s[1 * 33]); o.y = cvtpk(s[2 * 33], s[3 * 33]); o.z = cvtpk(s[4 * 33], s[5 * 33]); o.w = cvtpk(s[6 * 33], s[7 * 33]);
        *(u32x4*)(WT + (size_t)(n0 + n) * K + k0 + 8 * c) = o; }
    asm volatile("s_waitcnt lgkmcnt(0)" ::: "memory");
}
template <bool TO_BF16>
__device__ __forceinline__ void rms_rows4(const float* xrow, const float* __restrict__ gain, void* orow, int lane) {
    f32x4 v[4][4]; float s[4];
#pragma unroll
    for (int r = 0; r < 4; ++r)
#pragma unroll
        for (int j = 0; j < 4; ++j) v[r][j] = ((const f32x4*)(xrow + r * 1024) + lane)[64 * j];
#pragma unroll
    for (int r = 0; r < 4; ++r) { s[r] = 0.f;
#pragma unroll
        for (int j = 0; j < 4; ++j) s[r] += (v[r][j].x * v[r][j].x + v[r][j].y * v[r][j].y) + (v[r][j].z * v[r][j].z + v[r][j].w * v[r][j].w); }
#pragma unroll
    for (int o = 1; o < 64; o <<= 1) {
#pragma unroll
        for (int r = 0; r < 4; ++r) s[r] += __shfl_xor(s[r], o); }
    f32x4 gg[4];
#pragma unroll
    for (int j = 0; j < 4; ++j) gg[j] = ((const f32x4*)gain + lane)[64 * j];
#pragma unroll
    for (int r = 0; r < 4; ++r) { const float rinv = 1.f / sqrtf(s[r] * (1.f / 1024.f) + RMS_EPS);
#pragma unroll
        for (int j = 0; j < 4; ++j) { const f32x4 y = v[r][j] * rinv * gg[j];
            if (TO_BF16) { u32x2 w; w.x = cvtpk(y.x, y.y); w.y = cvtpk(y.z, y.w); ((u32x2*)((bf16_t*)orow + r * 1024) + lane)[64 * j] = w; }
            else ((f32x4*)((float*)orow + r * 1024) + lane)[64 * j] = y; } }
}

__device__ __forceinline__ void filter_item(const Args& A, int t0, bf16_t* __restrict__ gen, float* sm) {
    const int tid = threadIdx.x;
    float* z = sm;
    float* a = sm + 288;
    float* b = sm + 288 + 512;
    const float* w1 = A.in[I_FW1]; const float* b1 = A.in[I_FB1]; const float* w2 = A.in[I_FW2]; const float* b2 = A.in[I_FB2];
    const float* w3 = A.in[I_FW3]; const float* b3 = A.in[I_FB3]; const float* w4 = A.in[I_FW4]; const float* fr = A.in[I_FFREQ]; const float* fbias = A.in[I_FBIAS];
    __syncthreads();
    { const int tt = tid >> 6, j = tid & 63; const int t = t0 + tt;
      if (j < 33) { float v;
        if (j == 0) v = (float)t * (1.f / 2047.f);
        else { const int bi = (j - 1) & 15; const float bandv = 1e-4f + (15.f - 1e-4f) * ((float)bi / 15.f);
               const float w = 6.283185307179586f * (float)t * (1.f / 2048.f); float s, c; sincos_cw(w * bandv, s, c); v = (j <= 16) ? c : -s; }
        z[tt * 36 + j] = v; } }
    __syncthreads();
    const int tt = tid >> 6, o = tid & 63; const float fo = fr[o];
    { float s = b1[o];
#pragma unroll 3
      for (int j = 0; j < 33; ++j) s = fmaf(z[tt * 36 + j], w1[j * 64 + o], s);
      a[tt * 64 + o] = sin_cw(fo * s); }
    __syncthreads();
    { float s = b2[o];
#pragma unroll 8
      for (int j = 0; j < 64; ++j) s = fmaf(a[tt * 64 + j], w2[j * 64 + o], s);
      b[tt * 64 + o] = sin_cw(fo * s); }
    __syncthreads();
    { float s = b3[o];
#pragma unroll 8
      for (int j = 0; j < 64; ++j) s = fmaf(b[tt * 64 + j], w3[j * 64 + o], s);
      a[tt * 64 + o] = sin_cw(fo * s); }
    __syncthreads();
    for (int i = 0; i < 8; ++i) {
        const int col = tid + 512 * i; const int n = col >> 11, dir = (col >> 10) & 1, c = col & 1023;
        float acc[8];
#pragma unroll
        for (int q = 0; q < 8; ++q) acc[q] = 0.f;
#pragma unroll 2
        for (int k = 0; k < 64; k += 4) { const float w0 = w4[k * 4096 + col], w1 = w4[(k + 1) * 4096 + col], w2 = w4[(k + 2) * 4096 + col], w3 = w4[(k + 3) * 4096 + col];
#pragma unroll
            for (int q = 0; q < 8; ++q) { const f32x4 av = *(const f32x4*)(a + q * 64 + k);
                acc[q] = fmaf(av.x, w0, acc[q]); acc[q] = fmaf(av.y, w1, acc[q]); acc[q] = fmaf(av.z, w2, acc[q]); acc[q] = fmaf(av.w, w3, acc[q]); } }
        const float delta = fabsf(-3.0701134573253945f + (-15.350567286626973f + 3.0701134573253945f) * ((float)c * (1.f / 1023.f)));
        bf16_t* gr = gen + ((size_t)(n * 1024 + c)) * 4096;
#pragma unroll
        for (int q = 0; q < 8; ++q) { const int t = t0 + q; const float tv = (float)t * (1.f / 2047.f);
            float v = acc[q] * __builtin_amdgcn_exp2f(-1.4426950408889634f * tv * delta);
            if (dir == 0) { if (t == 0) v += fbias[n * 1024 + c]; gr[2047 - t] = f2bf(v); }
            else if (t > 0) gr[2047 + t] = f2bf(v); }
        if (t0 == 0 && dir == 1) gr[4095] = 0;
    }
}

__global__ void __launch_bounds__(512) fwd_megakernel(Args A) {
    extern __shared__ __attribute__((aligned(16))) unsigned char lds[];
    cg::grid_group grid = cg::this_grid();
    const int G = gridDim.x, bx = blockIdx.x, NGW = G * 8;
#define PHASE_IDS int tid = threadIdx.x; asm volatile("" : "+v"(tid)); const int lane = tid & 63, wave = __builtin_amdgcn_readfirstlane(tid >> 6), gw = bx * 8 + wave; (void)lane; (void)gw;
    unsigned char* ws = A.ws;
    bf16_t* W0t = (bf16_t*)(ws + WS_W0); bf16_t* Wuqt = (bf16_t*)(ws + WS_WUQ); bf16_t* Wukvt = (bf16_t*)(ws + WS_WUKV);
    bf16_t* Wo0t = (bf16_t*)(ws + WS_WO0); bf16_t* W1t = (bf16_t*)(ws + WS_W1); bf16_t* Wo1t = (bf16_t*)(ws + WS_WO1);
    float* rope = (float*)(ws + WS_ROPE); bf16_t* gen = (bf16_t*)(ws + WS_GEN);
    bf16_t* R1 = (bf16_t*)(ws + WS_R1); bf16_t* R2 = (bf16_t*)(ws + WS_R2);
    float* ssq = (float*)(ws + WS_SSQ); bf16_t* HB = (bf16_t*)(ws + WS_HB); bf16_t* cqn = (bf16_t*)(ws + WS_CQN); bf16_t* ckvn = (bf16_t*)(ws + WS_CKVN);
    bf16_t* kpe = (bf16_t*)(ws + WS_KPE); bf16_t* Qb = (bf16_t*)(ws + WS_Q); bf16_t* KV = (bf16_t*)(ws + WS_KV);
    bf16_t* UT = (bf16_t*)(ws + WS_UT); bf16_t* ZG = (bf16_t*)(ws + WS_ZG);
    LAS unsigned char* ldsl = (LAS unsigned char*)lds;
    volatile LAS unsigned* bst = (volatile LAS unsigned*)(ldsl + LDS_BYTES - 64);
    if (threadIdx.x < 2) bst[threadIdx.x] = 0u;
    __syncthreads();
    const XcdBarrier xbar = xcd_barrier_post((unsigned*)(ws + WS_BAR), bst);

    if constexpr (PH(0)) for (int rep_ = 0; rep_ < NREP(0); ++rep_) {
        PHASE_IDS
        float* scr = (float*)(lds + wave * 16384);
        constexpr int I0 = 16 * 56, I1 = 6 * 48, I2 = 4 * 64, I3 = 16 * 32, I4 = 16 * 128, I5 = 16 * 32;
        for (int it = gw; it < I0 + I1 + I2 + I3 + I4 + I5; it += NGW) {
            int r = it;
            if (r < I0) { transpose_item(A.in[I_L0WIN], 1024, 1728, 1792, W0t, 0, scr, r, lane); continue; } r -= I0;
            if (r < I1) { transpose_item(A.in[I_L0WUQ], 384, 1536, 1536, Wuqt, 1, scr, r, lane, A.in[I_L0QN]); continue; } r -= I1;
            if (r < I2) { transpose_item(A.in[I_L0WUKV], 256, 2048, 2048, Wukvt, 2, scr, r, lane, A.in[I_L0KVN]); continue; } r -= I2;
            if (r < I3) { transpose_item(A.in[I_L0WOUT], 1024, 1024, 1024, Wo0t, 2, scr, r, lane); continue; } r -= I3;
            if (r < I4) { transpose_item(A.in[I_L1WIN], 1024, 4096, 4096, W1t, 2, scr, r, lane, A.in[I_L1N]); continue; } r -= I4;
            transpose_item(A.in[I_L1WOUT], 1024, 1024, 1024, Wo1t, 2, scr, r, lane);
        }
        for (int i = bx * 512 + tid; i < 3 * NTOK; i += G * 512) ssq[i] = 0.f;
        for (int i = bx * 512 + tid; i < SEQ * 32; i += G * 512) {
            const int pos = i >> 5, j = i & 31; const float inv = __builtin_amdgcn_exp2f(-(float)j * (13.287712379549449f / 32.f));
            float s, c; sincos_cw((float)pos * inv, s, c); rope[i] = c; rope[SEQ * 32 + i] = s;
        }
        __syncthreads();
#ifndef P0_REP_F
#define P0_REP_F 1
#endif
#ifndef P0_REP_X
#define P0_REP_X 1
#endif
        for (int rf_ = 0; rf_ < P0_REP_F; ++rf_)
        for (int tg = bx; tg < SEQ / 8; tg += G) filter_item(A, tg * 8, gen, (float*)lds);
        for (int rx_ = 0; rx_ < P0_REP_X; ++rx_)
        for (int m = gw * 4; m < NTOK; m += NGW * 4) rms_rows4<true>(A.in[I_X] + (size_t)m * 1024, A.in[I_L0N], R1 + (size_t)m * 1024, lane);
    }
    xcd_barrier(xbar);
    if (A.ws == nullptr) grid.sync();
#ifdef EXTRA_SYNCS
    for (int i_ = 0; i_ < EXTRA_SYNCS; ++i_) grid.sync();
#endif
    if constexpr (PH(1)) for (int rep_ = 0; rep_ < NREP(1); ++rep_) {
        pg8::Gemm g{R1, W0t, NTOK, N0P, 1024}; pg8::StaticOrder S; S.init(NTOK, N0P, G, bx);
        EpiRows<F_G1> E{F_G1{cqn, ckvn, ssq, ssq + NTOK, kpe, R2, rope}};
        pg8::gemm_phase<EpiRows<F_G1>, pg8::StaticOrder, true, true>(ldsl, g, S, E);
    }
    xcd_barrier(xbar);
    if constexpr (PH(3)) for (int rep_ = 0; rep_ < NREP(3); ++rep_) {
        pg8::Gemm g{cqn, Wuqt, NTOK, 1536, 384}; pg8::StaticOrder S; S.init(NTOK, 1536, G, bx);
        EpiRows<F_G2Q> E{F_G2Q{Qb, rope}};
        pg8::gemm_phase<EpiRows<F_G2Q>, pg8::StaticOrder, true, true>(ldsl, g, S, E);
    }
    if constexpr (PH(4)) for (int rep_ = 0; rep_ < NREP(4); ++rep_) {
        pg8::Gemm g{ckvn, Wukvt, NTOK, 2048, 256}; pg8::StaticOrder S; S.init(NTOK, 2048, G, bx);
        EpiRows<F_G2KV> E{F_G2KV{KV, ssq + NTOK}};
        pg8::gemm_phase<EpiRows<F_G2KV>, pg8::StaticOrder, true, true>(ldsl, g, S, E);
    }
    xcd_barrier(xbar);
    if constexpr (PH(5)) for (int rep_ = 0; rep_ < NREP(5); ++rep_) {
        const int vcu = (G % 8 == 0) ? (bx % 8) * (G / 8) + bx / 8 : bx;
        for (int U = vcu; U < NB * NHEAD * 8; U += G) {
            const int qb = U & 7, bh = U >> 3, h = bh & 7, b = bh >> 3;
            const size_t row0 = (size_t)b * SEQ + qb * 256;
            att::attn_unit(Qb + row0 * 1536 + h * 192, KV + (size_t)b * SEQ * 2048 + h * 256, kpe + (size_t)b * SEQ * 64,
                           R2 + row0 * 1024 + h * 128, R1 + row0 * 1024 + h * 128, ssq + row0, (char*)lds, ldsl);
        }
    }
    xcd_barrier(xbar);
    if constexpr (PH(6)) for (int rep_ = 0; rep_ < NREP(6); ++rep_) {
        pg8::Gemm g{R1, Wo0t, NTOK, 1024, 1024}; pg8::StaticOrder S; S.init(NTOK, 1024, G, bx);
        EpiRows<F_RES1> E{F_RES1{A.in[I_X], A.out, HB, ssq + 2 * NTOK}};
        pg8::gemm_phase<EpiRows<F_RES1>, pg8::StaticOrder, true, true>(ldsl, g, S, E);
    }
    xcd_barrier(xbar);
    if constexpr (PH(8)) for (int rep_ = 0; rep_ < NREP(8); ++rep_) {
        pg8::Gemm g{W1t, HB, 3072, NTOK, 1024}; pg8::StaticOrder S; S.init(3072, NTOK, G, bx);
        EpiRows<F_UT> E{F_UT{UT, ssq + 2 * NTOK}};
        pg8::gemm_phase<EpiRows<F_UT>, pg8::StaticOrder, true, true>(ldsl, g, S, E);
    }
    if constexpr (PH(9)) for (int rep_ = 0; rep_ < NREP(9); ++rep_) {
        pg8::Gemm g{HB, W1t + (size_t)3072 * 1024, NTOK, 1024, 1024}; pg8::StaticOrder S; S.init(NTOK, 1024, G, bx);
        EpiRows<F_SILU1> E{F_SILU1{R2, ssq + 2 * NTOK}};
        pg8::gemm_phase<EpiRows<F_SILU1>, pg8::StaticOrder, true, true>(ldsl, g, S, E);
    }
    xcd_barrier(xbar);
    if constexpr (PH(10)) for (int rep_ = 0; rep_ < NREP(10); ++rep_) {
        const float* cw = A.in[I_L1CW]; const float* cbv = A.in[I_L1CB];
#ifndef CONV_PROBE_MAIN
#define CONV_PROBE_MAIN 0
#endif
        for (int c = bx; c < 1024; c += G) {
            const int cv = 2048 + c, c1 = c, c2 = 1024 + c;
            if (CONV_PROBE_MAIN) {
                hy::conv_channel<true>(gen + (size_t)c * 4096, UT + (size_t)cv * NTOK, cw[cv], cw[3072 + cv], cw[6144 + cv], cbv[cv],
                                       UT + (size_t)c1 * NTOK, cw[c1], cw[3072 + c1], cw[6144 + c1], cbv[c1], R1 + (size_t)c * NTOK, (char*)lds, false);
                hy::conv_channel<false>(gen + (size_t)(1024 + c) * 4096, UT + (size_t)cv * NTOK, 0.f, 0.f, 0.f, 0.f,
                                        UT + (size_t)c2 * NTOK, cw[c2], cw[3072 + c2], cw[6144 + c2], cbv[c2], ZG + (size_t)c * NTOK, (char*)lds, false);
            }
            hy::conv_channel<true>(gen + (size_t)c * 4096, UT + (size_t)cv * NTOK, cw[cv], cw[3072 + cv], cw[6144 + cv], cbv[cv],
                                   UT + (size_t)c1 * NTOK, cw[c1], cw[3072 + c1], cw[6144 + c1], cbv[c1], R1 + (size_t)c * NTOK, (char*)lds);
            __threadfence(); __syncthreads();
            hy::conv_channel<false>(gen + (size_t)(1024 + c) * 4096, R1 + (size_t)c * NTOK, 0.f, 0.f, 0.f, 0.f,
                                    UT + (size_t)c2 * NTOK, cw[c2], cw[3072 + c2], cw[6144 + c2], cbv[c2], ZG + (size_t)c * NTOK, (char*)lds);
        }
    }
    xcd_barrier(xbar);
    if constexpr (PH(11)) for (int rep_ = 0; rep_ < NREP(11); ++rep_) {
        PHASE_IDS
        bf16_t* tl = (bf16_t*)(lds + wave * 16384);
        for (int it = gw; it < 16 * 1024; it += NGW) {
            const int cb = it & 15, tb = it >> 4, c0 = cb * 64, tok0 = tb * 64;
#pragma unroll
            for (int k = 0; k < 8; ++k) { const int pi = lane + 64 * k, cc = pi >> 3, pc = pi & 7;
                *(u32x4*)(tl + cc * 72 + ((pc ^ k) << 3)) = *(const u32x4*)(ZG + (size_t)(c0 + cc) * NTOK + tok0 + pc * 8); }
            asm volatile("s_waitcnt lgkmcnt(0)" ::: "memory");
            const int j = lane >> 3, p = lane & 7;
#pragma unroll
            for (int t8 = 0; t8 < 8; ++t8) {
                const size_t rowo = (size_t)(tok0 + t8 * 8 + j) * 1024 + c0 + 8 * p;
                const u32x4 sgv = *(const u32x4*)(R2 + rowo);
                const bf16_t* tc = tl + (8 * p) * 72 + ((t8 ^ p) << 3) + j;
                float zv[8];
#pragma unroll
                for (int e = 0; e < 8; ++e) zv[e] = bf2f(tc[e * 72]);
                u32x4 o; o.x = cvtpk(zv[0] * bflo(sgv.x), zv[1] * bfhi(sgv.x)); o.y = cvtpk(zv[2] * bflo(sgv.y), zv[3] * bfhi(sgv.y));
                o.z = cvtpk(zv[4] * bflo(sgv.z), zv[5] * bfhi(sgv.z)); o.w = cvtpk(zv[6] * bflo(sgv.w), zv[7] * bfhi(sgv.w));
                *(u32x4*)(R1 + rowo) = o;
            }
            asm volatile("s_waitcnt lgkmcnt(0)" ::: "memory");
        }
    }
    xcd_barrier(xbar);
    if constexpr (PH(12)) for (int rep_ = 0; rep_ < NREP(12); ++rep_) {
        pg8::Gemm g{R1, Wo1t, NTOK, 1024, 1024}; pg8::StaticOrder S; S.init(NTOK, 1024, G, bx);
        EpiRows<F_RES> E{F_RES{A.out, A.out}};
        pg8::gemm_phase<EpiRows<F_RES>, pg8::StaticOrder, true, true>(ldsl, g, S, E);
    }
    xcd_barrier(xbar);
    if constexpr (PH(13)) for (int rep_ = 0; rep_ < NREP(13); ++rep_) { PHASE_IDS
        for (int m = gw * 4; m < NTOK; m += NGW * 4) rms_rows4<false>(A.out + (size_t)m * 1024, A.in[I_FN], A.out + (size_t)m * 1024, lane); }
}

extern "C" void kernel_launch(void* const* d_in, const int* in_sizes, int n_in, void* d_out, int out_size, void* d_ws, size_t ws_size, hipStream_t stream) {
    static int grid = 0;
    if (grid == 0) {
        if (n_in != 23 || in_sizes[0] != NTOK * DM || out_size != NTOK * DM || ws_size < WS_END) {
            fprintf(stderr, "kernel_launch: shape mismatch (n_in %d, in0 %d, out %d, ws %zu; need ws >= %zu)\n", n_in, n_in > 0 ? in_sizes[0] : -1, out_size, ws_size, (size_t)WS_END); grid = -1; return; }
        int dev = 0, cus = 0, per_cu = 0;
        hipGetDevice(&dev); hipDeviceGetAttribute(&cus, hipDeviceAttributeMultiprocessorCount, dev);
        if (hipFuncSetAttribute((const void*)fwd_megakernel, hipFuncAttributeMaxDynamicSharedMemorySize, LDS_BYTES) != hipSuccess) { fprintf(stderr, "kernel_launch: hipFuncSetAttribute failed\n"); grid = -1; return; }
        if (hipOccupancyMaxActiveBlocksPerMultiprocessor(&per_cu, (const void*)fwd_megakernel, 512, LDS_BYTES) != hipSuccess || per_cu < 1) { fprintf(stderr, "kernel_launch: occupancy query gave %d\n", per_cu); per_cu = 1; }
        (void)hipGetLastError();
        grid = cus * per_cu;
    }
    if (grid < 0) return;
    Args a{};
    for (int i = 0; i < 23; ++i) a.in[i] = (const float*)d_in[i];
    a.out = (float*)d_out; a.ws = (unsigned char*)d_ws;
    if (hipMemsetAsync((char*)d_ws + WS_BAR, 0, XCD_BAR_WORDS * 4, stream) != hipSuccess) { fprintf(stderr, "kernel_launch: memset of the barrier words failed\n"); return; }
    void* args[] = {&a};
    hipError_t e = hipLaunchCooperativeKernel((const void*)fwd_megakernel, dim3(grid), dim3(512), args, LDS_BYTES, stream);
    if (e != hipSuccess) fprintf(stderr, "cooperative launch failed: %s (grid %d)\n", hipGetErrorString(e), grid);
}
```
